# Optimizing an MI355X kernel written in HIP

```python
import math
import jax, jax.numpy as jnp
from jax import lax
import numpy as np

D_MODEL = 1024
BATCH = 32
SEQ = 256
DEPTH = 2
DEC_BATCH = 4
DEC_SEQ = 1024
PAST_LEN = 256

GRID_W = 64
HEAD_DIM = 64
ATTN_HEADS = 8
ATTN_KV_HEADS = 2
ATTN_GROUP = ATTN_HEADS // ATTN_KV_HEADS
DIFF_HEADS = 4
DIFF_QK_DIM = 2 * HEAD_DIM
DIFF_V_DIM = 2 * HEAD_DIM
RWKV_HEADS = 8
RWKV_HEAD_DIM = 64
BRANCH_WIDTH = 512
W_LORA = 64
A_LORA = 64
G_LORA = 128
D_FF = 2816
Q_BLOCK = 128
N_BRANCH = 3
N_MOD = 9
ROPE_THETA = 10000.0
ROPE_AXIS_DIM = HEAD_DIM // 2
DEEPNORM_ALPHA = (2.0 * DEPTH) ** 0.25
DEEPNORM_BETA = (8.0 * DEPTH) ** -0.25
LN_EPS = 1e-5
RMS_EPS = 1e-6
RWKV_GN_EPS = 64e-5
A_Q_W = ATTN_HEADS * HEAD_DIM
A_KV_W = ATTN_KV_HEADS * HEAD_DIM
B_QK_W = DIFF_HEADS * DIFF_QK_DIM
B_V_W = DIFF_HEADS * DIFF_V_DIM
C_IN_W = 3 * BRANCH_WIDTH + 2 * W_LORA + 2 * A_LORA + G_LORA
IN_SPLITS = (N_BRANCH * D_MODEL, A_Q_W, A_KV_W, A_KV_W, B_QK_W, B_QK_W, B_V_W, C_IN_W)
IN_WIDTH = sum(IN_SPLITS)
C_SPLITS = (BRANCH_WIDTH, BRANCH_WIDTH, BRANCH_WIDTH, 2 * W_LORA, 2 * A_LORA, G_LORA)

kernel_name = 'hybrid_flow_prefix_trunk'


def _split(x, sizes):
    return jnp.split(x, np.cumsum(sizes)[:-1].tolist(), axis=-1)


def layer_norm(x, g, b):
    xf = x.astype(jnp.float32)
    mu = jnp.mean(xf, -1, keepdims=True)
    var = jnp.mean(jnp.square(xf - mu), -1, keepdims=True)
    return ((xf - mu) * lax.rsqrt(var + LN_EPS) * g + b).astype(x.dtype)


def rms_norm(x, g):
    xf = x.astype(jnp.float32)
    return (xf * lax.rsqrt(jnp.mean(xf * xf, -1, keepdims=True) + RMS_EPS) * g).astype(x.dtype)


def axial_rope(T):
    n_rows = T // GRID_W
    row = jnp.repeat(jnp.arange(n_rows), GRID_W).astype(jnp.float32)
    col = jnp.tile(jnp.arange(GRID_W), n_rows).astype(jnp.float32)
    inv = 1.0 / (ROPE_THETA ** (jnp.arange(0, ROPE_AXIS_DIM, 2, dtype=jnp.float32) / ROPE_AXIS_DIM))
    ang = jnp.stack([row[:, None] * inv, col[:, None] * inv], axis=1)
    return jnp.cos(ang), jnp.sin(ang)


def apply_rope(x, cos, sin):
    shp = x.shape
    xr = x.astype(jnp.float32).reshape(shp[:-1] + (2, 2, ROPE_AXIS_DIM // 2))
    x1, x2 = xr[..., 0, :], xr[..., 1, :]
    out = jnp.stack([x1 * cos - x2 * sin, x2 * cos + x1 * sin], axis=-2)
    return out.reshape(shp).astype(x.dtype)


def map_query_blocks(fn, *qs):
    Tq = qs[0].shape[-2]
    nb = Tq // Q_BLOCK
    blocks = tuple(jnp.moveaxis(q.reshape(q.shape[:-2] + (nb, Q_BLOCK, q.shape[-1])), -3, 0) for q in qs)
    out = lax.map(lambda b: fn(*b), blocks)
    out = jnp.moveaxis(out, 0, -3)
    return out.reshape(out.shape[:-3] + (Tq, out.shape[-1]))


def _gqa_block(q, k, v):
    s = jnp.einsum('bhgqd,bhkd->bhgqk', q, k).astype(jnp.float32) * HEAD_DIM ** -0.5
    p = jax.nn.softmax(s, axis=-1).astype(v.dtype)
    return jnp.einsum('bhgqk,bhkd->bhgqd', p, v)


def _diff_block(q1, q2, k1, k2, v, lam):
    sc = HEAD_DIM ** -0.5
    s1 = jnp.einsum('bhqd,bhkd->bhqk', q1, k1).astype(jnp.float32) * sc
    s2 = jnp.einsum('bhqd,bhkd->bhqk', q2, k2).astype(jnp.float32) * sc
    p = jax.nn.softmax(s1, axis=-1) - lam * jax.nn.softmax(s2, axis=-1)
    return jnp.einsum('bhqk,bhkd->bhqd', p.astype(v.dtype), v)


def swiglu(x, w_in, w_out):
    a, b = jnp.split(x @ w_in, 2, axis=-1)
    return (jax.nn.silu(a) * b) @ w_out


def _rwkv_scan(S0, r, w, kk, a, k, v, reverse):
    def step(S, inp):
        r_t, w_t, kk_t, a_t, k_t, v_t = inp
        sa = jnp.einsum('bhvk,bhk->bhv', S, -kk_t)
        S = S * w_t[:, :, None, :] + sa[..., None] * (kk_t * a_t)[:, :, None, :] + v_t[..., None] * k_t[:, :, None, :]
        return S, jnp.einsum('bhvk,bhk->bhv', S, r_t)
    xs = tuple(jnp.moveaxis(t, 1, 0) for t in (r, w, kk, a, k, v))
    S, out = lax.scan(step, S0, xs, reverse=reverse)
    return S, jnp.moveaxis(out, 0, 1)


def rwkv7_bidir(cin, p, state0):
    B, T, _ = cin.shape
    f32 = jnp.float32
    prev = jnp.pad(cin[:, :-1], ((0, 0), (1, 0), (0, 0)))
    nxt = jnp.pad(cin[:, 1:], ((0, 0), (0, 1), (0, 0)))
    cin = cin + p['rwkv_mu'] * (0.5 * (prev + nxt) - cin)
    r, k, v, wl, al, gl = _split(cin, C_SPLITS)
    wl = wl.reshape(B, T, 2, W_LORA)
    al = al.reshape(B, T, 2, A_LORA)
    w_logit = (p['rwkv_w0'] + jnp.einsum('btdr,drc->btdc', jnp.tanh(wl), p['rwkv_w2'])).astype(f32)
    decay = jnp.exp(-jnp.exp(-jax.nn.softplus(-w_logit) - 0.5))
    a = jax.nn.sigmoid((p['rwkv_a0'] + jnp.einsum('btdr,drc->btdc', al, p['rwkv_a2'])).astype(f32))
    g = jax.nn.sigmoid(gl) @ p['rwkv_g2']
    heads = lambda t: t.reshape(t.shape[:-1] + (RWKV_HEADS, RWKV_HEAD_DIM))
    kk = heads(k * p['rwkv_k_k']).astype(f32)
    kk = kk * lax.rsqrt(jnp.sum(kk * kk, -1, keepdims=True) + 1e-12)
    k_h = heads(k[:, :, None, :] * (1.0 + (a - 1.0) * p['rwkv_k_a'])).astype(f32)
    a_h, w_h = heads(a), heads(decay)
    rh, vh = heads(r).astype(f32), heads(v).astype(f32)
    outs, states = [], []
    for d in range(2):
        S, o = _rwkv_scan(state0[:, d].astype(f32), rh, w_h[:, :, d], kk, a_h[:, :, d], k_h[:, :, d], vh, reverse=(d == 1))
        outs.append(o)
        states.append(S)
    o = outs[0] + outs[1]
    mu = jnp.mean(o, -1, keepdims=True)
    var = jnp.mean(jnp.square(o - mu), -1, keepdims=True)
    o = ((o - mu) * lax.rsqrt(var + RWKV_GN_EPS)).reshape(B, T, BRANCH_WIDTH) * p['rwkv_gn_g'] + p['rwkv_gn_b']
    bonus = jnp.sum(rh[:, :, None] * k_h * p['rwkv_r_k'], -1, keepdims=True) * vh[:, :, None]
    o = o + jnp.sum(bonus, axis=2).reshape(B, T, BRANCH_WIDTH)
    return (o * g).astype(cin.dtype), jnp.stack(states, axis=1)


def mixing_sublayer(h, p, lam_init, ctx):
    B, T, _ = h.shape
    gates, aq, ak, av, bq, bk, bv, cin = _split(h @ p['w_in'], IN_SPLITS)
    latent = ctx is not None
    if latent:
        cos, sin = axial_rope(T)
        rope = lambda t: apply_rope(t, cos, sin)
    else:
        rope = lambda t: t
    qa = rms_norm(aq.reshape(B, T, ATTN_KV_HEADS, ATTN_GROUP, HEAD_DIM), p['qk_norm_g'][0]).transpose(0, 2, 3, 1, 4)
    ka = rms_norm(ak.reshape(B, T, ATTN_KV_HEADS, HEAD_DIM), p['qk_norm_g'][1]).transpose(0, 2, 1, 3)
    va = av.reshape(B, T, ATTN_KV_HEADS, HEAD_DIM).transpose(0, 2, 1, 3)
    qb = bq.reshape(B, T, DIFF_HEADS, DIFF_QK_DIM).transpose(0, 2, 1, 3)
    kb = bk.reshape(B, T, DIFF_HEADS, DIFF_QK_DIM).transpose(0, 2, 1, 3)
    vb = bv.reshape(B, T, DIFF_HEADS, DIFF_V_DIM).transpose(0, 2, 1, 3)
    q1, q2 = rope(qb[..., :HEAD_DIM]), rope(qb[..., HEAD_DIM:])
    if latent:
        ctx_ka, ctx_va, ctx_kb, ctx_vb, state0 = ctx
        keys_a = jnp.concatenate([rope(ka), ctx_ka], axis=2)
        vals_a = jnp.concatenate([va, ctx_va], axis=2)
        k1 = jnp.concatenate([rope(kb[..., :HEAD_DIM]), ctx_kb[..., :HEAD_DIM]], axis=2)
        k2 = jnp.concatenate([rope(kb[..., HEAD_DIM:]), ctx_kb[..., HEAD_DIM:]], axis=2)
        vals_b = jnp.concatenate([vb, ctx_vb], axis=2)
    else:
        keys_a, vals_a = ka, va
        k1, k2 = kb[..., :HEAD_DIM], kb[..., HEAD_DIM:]
        vals_b = vb
        state0 = jnp.zeros((B, 2, RWKV_HEADS, RWKV_HEAD_DIM, RWKV_HEAD_DIM), jnp.float32)
    out_a = map_query_blocks(lambda q: _gqa_block(q, keys_a, vals_a), rope(qa))
    out_a = out_a.transpose(0, 3, 1, 2, 4).reshape(B, T, A_Q_W)
    lv = p['diff_lambda'].astype(jnp.float32)
    lam = jnp.exp(jnp.dot(lv[0], lv[1])) - jnp.exp(jnp.dot(lv[2], lv[3])) + lam_init
    out_b = map_query_blocks(lambda x1, x2: _diff_block(x1, x2, k1, k2, vals_b, lam), q1, q2)
    out_b = rms_norm(out_b, p['diff_subln_g']) * (1.0 - lam_init)
    out_b = out_b.transpose(0, 2, 1, 3).reshape(B, T, B_V_W)
    out_c, state = rwkv7_bidir(cin, p, state0)
    branches = jnp.stack([out_a, out_b, out_c], axis=2)
    up = jnp.einsum('btim,imd->btid', branches, p['w_up'])
    gate = jax.nn.sigmoid(gates.reshape(B, T, N_BRANCH, D_MODEL))
    out = jnp.sum(gate * up, axis=2) @ p['w_out']
    return out, (ka, va, kb, vb, state.astype(h.dtype))


def modulation(cvec, p):
    m = jax.nn.silu(cvec) @ p['w_mod'] + p['b_mod']
    return m.reshape(cvec.shape[0], N_MOD, D_MODEL)


def trunk_layer(x, mod, p, lam_init, ctx):
    m = lambda i: mod[:, None, i]
    adaln = lambda t, s: t * (1.0 + m(3 * s + 1)) + m(3 * s)
    h = swiglu(adaln(x, 0), p['ffn_w_in'][0], p['ffn_w_out'][0])
    x = layer_norm(DEEPNORM_ALPHA * x + 0.5 * m(2) * h, p['ln_g'][0], p['ln_b'][0])
    h, ctx_out = mixing_sublayer(adaln(x, 1), p, lam_init, ctx)
    x = layer_norm(DEEPNORM_ALPHA * x + m(5) * h, p['ln_g'][1], p['ln_b'][1])
    h = swiglu(adaln(x, 2), p['ffn_w_in'][1], p['ffn_w_out'][1])
    x = layer_norm(DEEPNORM_ALPHA * x + 0.5 * m(8) * h, p['ln_g'][2], p['ln_b'][2])
    return x, ctx_out


def setup_inputs(seed: int = 0) -> dict:
    key = jax.random.key(seed)
    ks = iter(jax.random.split(key, 40))
    nrm = lambda shape, s: jax.random.normal(next(ks), shape, jnp.float32) * s
    L, D = DEPTH, D_MODEL
    return {
        'x_prompt': nrm((BATCH, SEQ, D), 1.0),
        'x_sample': nrm((DEC_BATCH, DEC_SEQ, D), 1.0),
        'cache_attn_k': nrm((DEC_BATCH, L, ATTN_KV_HEADS, PAST_LEN, HEAD_DIM), 1.0),
        'cache_attn_v': nrm((DEC_BATCH, L, ATTN_KV_HEADS, PAST_LEN, HEAD_DIM), 1.0),
        'cache_diff_k': nrm((DEC_BATCH, L, DIFF_HEADS, PAST_LEN, DIFF_QK_DIM), 1.0),
        'cache_diff_v': nrm((DEC_BATCH, L, DIFF_HEADS, PAST_LEN, DIFF_V_DIM), 1.0),
        'state_rwkv': nrm((DEC_BATCH, L, 2, RWKV_HEADS, RWKV_HEAD_DIM, RWKV_HEAD_DIM), 0.3),
        'c': nrm((DEC_BATCH, D), 1.0),
        'c_ctx': nrm((D,), 1.0),
        'w_mod': nrm((L, D, N_MOD * D), 0.5 * D ** -0.5),
        'b_mod': nrm((L, N_MOD * D), 0.02),
        'ln_g': 1.0 + nrm((L, 3, D), 0.02),
        'ln_b': nrm((L, 3, D), 0.02),
        'ffn_w_in': nrm((L, 2, D, 2 * D_FF), D ** -0.5),
        'ffn_w_out': nrm((L, 2, D_FF, D), DEEPNORM_BETA * D_FF ** -0.5),
        'w_in': nrm((L, D, IN_WIDTH), D ** -0.5),
        'qk_norm_g': 1.0 + nrm((L, 2, HEAD_DIM), 0.02),
        'diff_lambda': nrm((L, 4, HEAD_DIM), 0.1),
        'diff_subln_g': 1.0 + nrm((L, DIFF_V_DIM), 0.02),
        'rwkv_mu': jax.random.uniform(next(ks), (L, C_IN_W), jnp.float32),
        'rwkv_w0': -2.0 + nrm((L, 2, BRANCH_WIDTH), 0.5),
        'rwkv_w2': nrm((L, 2, W_LORA, BRANCH_WIDTH), 0.1),
        'rwkv_a0': nrm((L, 2, BRANCH_WIDTH), 0.1),
        'rwkv_a2': nrm((L, 2, A_LORA, BRANCH_WIDTH), A_LORA ** -0.5),
        'rwkv_g2': nrm((L, G_LORA, BRANCH_WIDTH), G_LORA ** -0.5),
        'rwkv_k_k': 1.0 + nrm((L, BRANCH_WIDTH), 0.1),
        'rwkv_k_a': 1.0 + nrm((L, BRANCH_WIDTH), 0.1),
        'rwkv_r_k': nrm((L, RWKV_HEADS, RWKV_HEAD_DIM), 0.1),
        'rwkv_gn_g': 1.0 + nrm((L, BRANCH_WIDTH), 0.02),
        'rwkv_gn_b': nrm((L, BRANCH_WIDTH), 0.02),
        'w_up': nrm((L, N_BRANCH, BRANCH_WIDTH, D), BRANCH_WIDTH ** -0.5),
        'w_out': nrm((L, D, D), DEEPNORM_BETA * D ** -0.5),
    }


def reference(x_prompt, x_sample, cache_attn_k, cache_attn_v, cache_diff_k, cache_diff_v, state_rwkv, c, c_ctx,
              w_mod, b_mod, ln_g, ln_b, ffn_w_in, ffn_w_out, w_in, qk_norm_g, diff_lambda, diff_subln_g,
              rwkv_mu, rwkv_w0, rwkv_w2, rwkv_a0, rwkv_a2, rwkv_g2, rwkv_k_k, rwkv_k_a, rwkv_r_k,
              rwkv_gn_g, rwkv_gn_b, w_up, w_out):
    y_prompt, y_sample = x_prompt, x_sample
    n_ak, n_av, n_dk, n_dv, n_st = [], [], [], [], []
    for l in range(DEPTH):
        p = {'w_mod': w_mod[l], 'b_mod': b_mod[l], 'ln_g': ln_g[l], 'ln_b': ln_b[l],
             'ffn_w_in': ffn_w_in[l], 'ffn_w_out': ffn_w_out[l], 'w_in': w_in[l], 'qk_norm_g': qk_norm_g[l],
             'diff_lambda': diff_lambda[l], 'diff_subln_g': diff_subln_g[l], 'rwkv_mu': rwkv_mu[l],
             'rwkv_w0': rwkv_w0[l], 'rwkv_w2': rwkv_w2[l], 'rwkv_a0': rwkv_a0[l], 'rwkv_a2': rwkv_a2[l],
             'rwkv_g2': rwkv_g2[l], 'rwkv_k_k': rwkv_k_k[l], 'rwkv_k_a': rwkv_k_a[l], 'rwkv_r_k': rwkv_r_k[l],
             'rwkv_gn_g': rwkv_gn_g[l], 'rwkv_gn_b': rwkv_gn_b[l], 'w_up': w_up[l], 'w_out': w_out[l]}
        lam_init = 0.8 - 0.6 * math.exp(-0.3 * l)
        y_prompt, (ka, va, kb, vb, st) = trunk_layer(y_prompt, modulation(c_ctx[None], p), p, lam_init, None)
        n_ak.append(ka); n_av.append(va); n_dk.append(kb); n_dv.append(vb); n_st.append(st)
        ctx = (cache_attn_k[:, l], cache_attn_v[:, l], cache_diff_k[:, l], cache_diff_v[:, l], state_rwkv[:, l])
        y_sample, _ = trunk_layer(y_sample, modulation(c, p), p, lam_init, ctx)
    new_attn_k = jnp.stack(n_ak, axis=1)
    new_attn_v = jnp.stack(n_av, axis=1)
    new_diff_k = jnp.stack(n_dk, axis=1)
    new_diff_v = jnp.stack(n_dv, axis=1)
    new_state_rwkv = jnp.stack(n_st, axis=1)
    return (y_prompt, y_sample, new_attn_k, new_attn_v, new_diff_k, new_diff_v, new_state_rwkv)
```

```cpp
#include <hip/hip_runtime.h>
#include <cstdio>
#include <cstdint>
#ifndef MK_ONE_LAUNCH
#define MK_ONE_LAUNCH 1
#endif
#define GAS __attribute__((address_space(1)))
#define LAS __attribute__((address_space(3)))
typedef unsigned short bf16;
typedef unsigned v4u __attribute__((ext_vector_type(4)));
typedef float f32x4 __attribute__((ext_vector_type(4)));
typedef short bf16x8 __attribute__((ext_vector_type(8)));
typedef GAS unsigned gu32;
typedef GAS unsigned long long gu64;
#define RLX_AGENT __ATOMIC_RELAXED, __HIP_MEMORY_SCOPE_AGENT
#define LDS_WAIT() asm volatile("s_waitcnt lgkmcnt(0)" ::: "memory")
#define VM_WAIT() asm volatile("s_waitcnt vmcnt(0)" ::: "memory")
__device__ __forceinline__ unsigned long long rt() { return __builtin_amdgcn_s_memrealtime(); }
__device__ __forceinline__ unsigned f2bf(float f) { unsigned u = __builtin_bit_cast(unsigned, f); return (u + 0x7fffu + ((u >> 16) & 1u)) >> 16; }
__device__ __forceinline__ unsigned pk2(float lo, float hi) { return f2bf(lo) | (f2bf(hi) << 16); }
namespace pg8 {
#define PG8_LAS __attribute__((address_space(3)))
typedef unsigned short bf16_t;
typedef short bf16x8 __attribute__((ext_vector_type(8)));
typedef float f32x4 __attribute__((ext_vector_type(4)));
typedef unsigned u32x4 __attribute__((ext_vector_type(4)));
constexpr int BM = 256, BK = 64, HALF = 128, HTB = HALF * BK * 2  , STAGE_BYTES = 8 * HTB, NXCD = 8, WGM = 8;

__host__ __device__ __forceinline__ int lds_byte(int r, int c) { const int st = (r >> 4) * 2 + (c >> 5), rr = r & 15, cc = c & 31, ob = rr * 64 + cc * 2; return st * 1024 + (ob ^ (((ob >> 9) & 1) << 5)); }
__host__ __device__ __forceinline__ void stage_rc(int b, int& R, int& C) { const int st = b / 1024, sb = b % 1024, swz = sb ^ (((sb >> 9) & 1) << 5); R = (st >> 1) * 16 + swz / 64; C = (st & 1) * 32 + (swz % 64) / 2; }
__host__ __device__ __forceinline__ int perm32(int rho) { const int n = rho >> 4, i = rho & 15; return 8 * (i >> 2) + 4 * n + (i & 3); }

struct Unit { int pm, pn; };
struct Gemm { const bf16_t* A; const bf16_t* Bt; int M, N, K; };

struct StaticOrder {
    int nM, nN, nwg, G, c;
    __host__ __device__ void init(int M, int N, int G_, int c_) { nM = M / BM; nN = N / BM; nwg = nM * nN; G = G_; c = c_; }
    __host__ __device__ bool next(int i, Unit& u) const {
        const long L = (long)i * G + c; if (L >= nwg) return false;
        int wgid = (int)L; { const int q = nwg / NXCD, r = nwg % NXCD, xcd = wgid % NXCD, off = wgid / NXCD; wgid = (xcd < r ? xcd * (q + 1) : r * (q + 1) + (xcd - r) * q) + off; }
        const int nig = WGM * nN, gid = wgid / nig, fm = gid * WGM, gsz = (nM - fm) < WGM ? (nM - fm) : WGM;
        u.pm = fm + ((wgid % nig) % gsz); u.pn = (wgid % nig) / gsz; return true;
    }
    __device__ __forceinline__ void a_ready(const Unit&) const {}
    __device__ __forceinline__ void done(const Unit&) const {}
};

__device__ __forceinline__ unsigned cvt_pk_bf16(float lo, float hi) { unsigned r; asm volatile("v_cvt_pk_bf16_f32 %0, %1, %2" : "=v"(r) : "v"(lo), "v"(hi)); return r; }
template <class Epi, class Sched, bool ALIGN_EPI = false, bool SP2 = false>
__device__ __forceinline__ void gemm_phase(PG8_LAS unsigned char* lds, const Gemm g, const Sched& S, const Epi& E) {
    int tid_ = threadIdx.x; asm volatile("" : "+v"(tid_));
    const int tid = tid_, wid = __builtin_amdgcn_readfirstlane(tid >> 6), lane = tid & 63, wr = wid >> 2, wc = wid & 3, fr = lane & 15, fq = lane >> 4;
    const int K = g.K, nt = K / BK;
    unsigned voffA[2], voffB[2];
#pragma unroll
    for (int i = 0; i < 2; ++i) { int R, C; stage_rc(tid * 16 + i * 8192, R, C); const int Rb = Epi::PERM ? ((R & ~31) + perm32(R & 31)) : R;
        voffA[i] = (unsigned)(R * K + C) * 2u; voffB[i] = (unsigned)(Rb * K + C) * 2u; }
    const size_t kstep = (size_t)(BK * 2);
    const size_t hstep = (size_t)HALF * K * 2;
    const size_t tstep = 2 * hstep;
    const unsigned ldsw = (unsigned)wid * 1024u;
    const int aoff = lds_byte(wr * 64 + fr, fq * 8), boff = lds_byte(wc * 32 + fr, fq * 8);
#define PG8_SA(b, h) (((b) * 2 + (h)) * HTB)
#define PG8_SB(b, h) ((4 + (b) * 2 + (h)) * HTB)
#define PG8_STAGE(bufoff, gbase, voff) do { _Pragma("unroll") for (int _i = 0; _i < 2; ++_i) \
        __builtin_amdgcn_global_load_lds((const unsigned*)((const char*)(gbase) + (voff)[_i]), (PG8_LAS unsigned*)(lds + (bufoff) + ldsw + _i * 8192), 16, 0, 0); } while (0)
#define PG8_LDA(dst, b, h) do { _Pragma("unroll") for (int m = 0; m < 4; ++m) _Pragma("unroll") for (int k = 0; k < 2; ++k) dst[m][k] = *(const PG8_LAS bf16x8*)(lds + PG8_SA(b, h) + aoff + m * 2048 + k * 1024); } while (0)
#define PG8_LDB(dst, b, h) do { _Pragma("unroll") for (int n = 0; n < 2; ++n) _Pragma("unroll") for (int k = 0; k < 2; ++k) dst[n][k] = *(const PG8_LAS bf16x8*)(lds + PG8_SB(b, h) + boff + n * 2048 + k * 1024); } while (0)
#define PG8_MMA(ai, bj, At, Bt) do { __builtin_amdgcn_s_setprio(1); _Pragma("unroll") for (int m = 0; m < 4; ++m) _Pragma("unroll") for (int n = 0; n < 2; ++n) _Pragma("unroll") for (int k = 0; k < 2; ++k) \
        acc[ai][bj][m][n] = __builtin_amdgcn_mfma_f32_16x16x32_bf16(Bt[n][k], At[m][k], acc[ai][bj][m][n], 0, 0, 0); __builtin_amdgcn_s_setprio(0); } while (0)
#define PG8_WAIT_V(n) asm volatile("s_waitcnt vmcnt(" #n ")" ::: "memory")
#define PG8_WAIT_L(n) asm volatile("s_waitcnt lgkmcnt(" #n ")" ::: "memory")
#define PG8_BAR __builtin_amdgcn_s_barrier()
#define PG8_SCHED __builtin_amdgcn_sched_barrier(0)
    Unit cur, nxt; int ui = 0;
    if (!S.next(0, cur)) return;
    f32x4 acc[2][2][4][2];
#pragma unroll
    for (int a = 0; a < 2; ++a)
#pragma unroll
        for (int b = 0; b < 2; ++b)
#pragma unroll
            for (int m = 0; m < 4; ++m)
#pragma unroll
                for (int n = 0; n < 2; ++n) acc[a][b][m][n] = (f32x4){0.f, 0.f, 0.f, 0.f};
    bf16x8 At[4][2], B0[2][2], B1[2][2];
    const char* cA = (const char*)g.A + (size_t)cur.pm * tstep; const char* cB = (const char*)g.Bt + (size_t)cur.pn * tstep;
    S.a_ready(cur);
    if constexpr (SP2) {
        PG8_STAGE(PG8_SB(0, 0), cB, voffB); PG8_STAGE(PG8_SB(0, 1), cB + hstep, voffB); PG8_STAGE(PG8_SA(0, 0), cA, voffA); PG8_STAGE(PG8_SA(0, 1), cA + hstep, voffA);
        if (wr == 1) PG8_BAR;
        PG8_WAIT_V(2); PG8_BAR;
        PG8_STAGE(PG8_SB(1, 0), cB + kstep, voffB); PG8_STAGE(PG8_SA(1, 0), cA + kstep, voffA); PG8_STAGE(PG8_SB(1, 1), cB + hstep + kstep, voffB);
        PG8_WAIT_V(6); PG8_BAR;
    } else {
        PG8_STAGE(PG8_SB(0, 0), cB, voffB); PG8_STAGE(PG8_SA(0, 0), cA, voffA); PG8_STAGE(PG8_SB(0, 1), cB + hstep, voffB); PG8_STAGE(PG8_SA(0, 1), cA + hstep, voffA);
        if (wr == 1) PG8_BAR;
        PG8_WAIT_V(4); PG8_BAR;
        PG8_STAGE(PG8_SB(1, 0), cB + kstep, voffB); PG8_STAGE(PG8_SA(1, 0), cA + kstep, voffA); PG8_STAGE(PG8_SB(1, 1), cB + hstep + kstep, voffB);
        PG8_WAIT_V(6); PG8_BAR;
    }
    for (;;) {
        const bool has_next = S.next(ui + 1, nxt);
        const char* nA = has_next ? (const char*)g.A + (size_t)nxt.pm * tstep : cA; const char* nB = has_next ? (const char*)g.Bt + (size_t)nxt.pn * tstep : cB;
        for (int t = 0; t < nt; t += 2) {
            const bool last = (t == nt - 2);
            const char* a1 = cA + (size_t)(t + 1) * kstep;
            const char* a2 = last ? nA : cA + (size_t)(t + 2) * kstep; const char* b2 = last ? nB : cB + (size_t)(t + 2) * kstep;
            const char* a3 = a2 + kstep; const char* b3 = b2 + kstep;
            if (last && has_next) S.a_ready(nxt);
            if constexpr (SP2) {
            PG8_LDB(B0, 0, 0); PG8_LDB(B1, 0, 1); PG8_SCHED; PG8_LDA(At, 0, 0); PG8_STAGE(PG8_SA(1, 1), a1 + hstep, voffA);
            PG8_WAIT_V(8); PG8_WAIT_L(0); PG8_BAR; PG8_MMA(0, 0, At, B0); PG8_MMA(0, 1, At, B1); PG8_BAR; PG8_SCHED;
            PG8_LDA(At, 0, 1); PG8_STAGE(PG8_SB(0, 0), b2, voffB); PG8_STAGE(PG8_SB(0, 1), b2 + hstep, voffB); PG8_STAGE(PG8_SA(0, 0), a2, voffA);
            PG8_WAIT_V(8); PG8_WAIT_L(0); PG8_BAR; PG8_MMA(1, 0, At, B0); PG8_MMA(1, 1, At, B1); PG8_BAR; PG8_SCHED;
            PG8_LDB(B0, 1, 0); PG8_LDB(B1, 1, 1); PG8_SCHED; PG8_LDA(At, 1, 0); PG8_STAGE(PG8_SA(0, 1), a2 + hstep, voffA);
            PG8_WAIT_V(8); PG8_WAIT_L(0); PG8_BAR; PG8_MMA(0, 0, At, B0); PG8_MMA(0, 1, At, B1); PG8_BAR; PG8_SCHED;
            PG8_LDA(At, 1, 1); PG8_STAGE(PG8_SB(1, 0), b3, voffB); PG8_STAGE(PG8_SB(1, 1), b3 + hstep, voffB); PG8_STAGE(PG8_SA(1, 0), a3, voffA);
            PG8_WAIT_V(8); PG8_WAIT_L(0); PG8_BAR; PG8_MMA(1, 0, At, B0); PG8_MMA(1, 1, At, B1); PG8_BAR; PG8_SCHED;
            } else {
            PG8_LDB(B0, 0, 0); PG8_SCHED; PG8_LDA(At, 0, 0); PG8_STAGE(PG8_SA(1, 1), a1 + hstep, voffA);
            PG8_WAIT_L(8); PG8_BAR; PG8_WAIT_L(0); PG8_MMA(0, 0, At, B0); PG8_BAR; PG8_SCHED;
            PG8_LDB(B1, 0, 1); PG8_STAGE(PG8_SB(0, 0), b2, voffB);
            PG8_BAR; PG8_WAIT_L(0); PG8_MMA(0, 1, At, B1); PG8_BAR;
            PG8_LDA(At, 0, 1); PG8_STAGE(PG8_SA(0, 0), a2, voffA);
            PG8_BAR; PG8_WAIT_L(0); PG8_MMA(1, 0, At, B0); PG8_BAR; PG8_SCHED;
            PG8_STAGE(PG8_SB(0, 1), b2 + hstep, voffB);
            PG8_WAIT_V(6); PG8_BAR; PG8_MMA(1, 1, At, B1); PG8_BAR;
            PG8_LDB(B0, 1, 0); PG8_SCHED; PG8_LDA(At, 1, 0); PG8_STAGE(PG8_SA(0, 1), a2 + hstep, voffA);
            PG8_WAIT_L(8); PG8_BAR; PG8_WAIT_L(0); PG8_MMA(0, 0, At, B0); PG8_BAR; PG8_SCHED;
            PG8_LDB(B1, 1, 1); PG8_STAGE(PG8_SB(1, 0), b3, voffB);
            PG8_BAR; PG8_WAIT_L(0); PG8_MMA(0, 1, At, B1); PG8_BAR;
            PG8_LDA(At, 1, 1); PG8_STAGE(PG8_SA(1, 0), a3, voffA);
            PG8_BAR; PG8_WAIT_L(0); PG8_MMA(1, 0, At, B0); PG8_BAR; PG8_SCHED;
            PG8_STAGE(PG8_SB(1, 1), b3 + hstep, voffB);
            PG8_WAIT_V(6); PG8_BAR; PG8_MMA(1, 1, At, B1); PG8_BAR;
            }
        }
        if constexpr (ALIGN_EPI) { if (wr == 0) PG8_BAR; }
        if constexpr (!Epi::AFTER_DRAIN) { E(acc, cur, wr, wc, fr, fq); S.done(cur); }
        if (!has_next) break;
#pragma unroll
        for (int a = 0; a < 2; ++a)
#pragma unroll
            for (int b = 0; b < 2; ++b)
#pragma unroll
                for (int m = 0; m < 4; ++m)
#pragma unroll
                    for (int n = 0; n < 2; ++n) acc[a][b][m][n] = (f32x4){0.f, 0.f, 0.f, 0.f};
        cur = nxt; cA = nA; cB = nB; ++ui;
        if constexpr (ALIGN_EPI) { if (wr == 1) PG8_BAR; }
    }
    PG8_WAIT_V(0);
    if constexpr (!ALIGN_EPI) { if (wr == 0) PG8_BAR; }
    PG8_BAR;
    if constexpr (Epi::AFTER_DRAIN) { E.fused(acc, cur, wr, wc, fr, fq, lds, wid, lane); S.done(cur); }
#undef PG8_SA
#undef PG8_SB
#undef PG8_STAGE
#undef PG8_LDA
#undef PG8_LDB
#undef PG8_MMA
#undef PG8_WAIT_V
#undef PG8_WAIT_L
#undef PG8_BAR
#undef PG8_SCHED
}
}
namespace pg8 {
typedef unsigned u32x2 __attribute__((ext_vector_type(2)));
__device__ __forceinline__ float sigmoidf_(float x) { return 1.0f / (1.0f + __expf(-x)); }
struct EpiBf {
    static constexpr bool PERM = true, AFTER_DRAIN = false;
    bf16_t* O; int ldc; int act;
    __device__ __forceinline__ void operator()(const f32x4 (&acc)[2][2][4][2], const Unit& u, int wr, int wc, int fr, int fq) const {
        const int row0 = u.pm * BM + wr * 64 + fr, col0 = u.pn * BM + wc * 32 + 8 * fq;
#pragma unroll
        for (int ai = 0; ai < 2; ++ai)
#pragma unroll
            for (int m = 0; m < 4; ++m) { bf16_t* rowp = O + (size_t)(row0 + ai * HALF + m * 16) * ldc + col0;
#pragma unroll
                for (int bj = 0; bj < 2; ++bj) { f32x4 v0 = acc[ai][bj][m][0], v1 = acc[ai][bj][m][1];
                    if (act == 1) {
#pragma unroll
                        for (int j = 0; j < 4; ++j) { v0[j] = sigmoidf_(v0[j]); v1[j] = sigmoidf_(v1[j]); } }
                    u32x4 w; w.x = cvt_pk_bf16(v0[0], v0[1]); w.y = cvt_pk_bf16(v0[2], v0[3]); w.z = cvt_pk_bf16(v1[0], v1[1]); w.w = cvt_pk_bf16(v1[2], v1[3]);
                    *(u32x4*)(rowp + bj * HALF) = w; } }
    }
};
struct EpiSwiglu {
    static constexpr bool PERM = true, AFTER_DRAIN = false;
    bf16_t* O; int ldc;
    __device__ __forceinline__ void operator()(const f32x4 (&acc)[2][2][4][2], const Unit& u, int wr, int wc, int fr, int fq) const {
        const int row0 = u.pm * BM + wr * 64 + fr, col0 = u.pn * HALF + wc * 32 + 8 * fq;
#pragma unroll
        for (int ai = 0; ai < 2; ++ai)
#pragma unroll
            for (int m = 0; m < 4; ++m) { bf16_t* rowp = O + (size_t)(row0 + ai * HALF + m * 16) * ldc + col0;
                f32x4 v0, v1;
#pragma unroll
                for (int j = 0; j < 4; ++j) { const float a0 = acc[ai][0][m][0][j], a1 = acc[ai][0][m][1][j];
                    v0[j] = a0 * sigmoidf_(a0) * acc[ai][1][m][0][j]; v1[j] = a1 * sigmoidf_(a1) * acc[ai][1][m][1][j]; }
                u32x4 w; w.x = cvt_pk_bf16(v0[0], v0[1]); w.y = cvt_pk_bf16(v0[2], v0[3]); w.z = cvt_pk_bf16(v1[0], v1[1]); w.w = cvt_pk_bf16(v1[2], v1[3]);
                *(u32x4*)rowp = w; }
    }
};
struct EpiF32 {
    static constexpr bool PERM = false, AFTER_DRAIN = false;
    float* C; int ldc;
    __device__ __forceinline__ void operator()(const f32x4 (&acc)[2][2][4][2], const Unit& u, int wr, int wc, int fr, int fq) const {
        const int row0 = u.pm * BM + wr * 64 + fr, col0 = u.pn * BM + wc * 32 + 4 * fq;
#pragma unroll
        for (int ai = 0; ai < 2; ++ai)
#pragma unroll
            for (int m = 0; m < 4; ++m) { float* rowp = C + (size_t)(row0 + ai * HALF + m * 16) * ldc + col0;
#pragma unroll
                for (int bj = 0; bj < 2; ++bj)
#pragma unroll
                    for (int n = 0; n < 2; ++n) *(f32x4*)(rowp + bj * HALF + n * 16) = acc[ai][bj][m][n]; }
    }
};
struct EpiUp {
    static constexpr bool PERM = false, AFTER_DRAIN = false;
    const bf16_t* gates; int ldg; int gcol0; float* T; bf16_t* GU; int mode;
    __device__ __forceinline__ void operator()(const f32x4 (&acc)[2][2][4][2], const Unit& u, int wr, int wc, int fr, int fq) const {
        const int row0 = u.pm * BM + wr * 64 + fr, col0 = u.pn * BM + wc * 32 + 4 * fq;
#pragma unroll
        for (int ai = 0; ai < 2; ++ai)
#pragma unroll
            for (int m = 0; m < 4; ++m) { const size_t row = (size_t)(row0 + ai * HALF + m * 16);
#pragma unroll
                for (int bj = 0; bj < 2; ++bj)
#pragma unroll
                    for (int n = 0; n < 2; ++n) { const int col = col0 + bj * HALF + n * 16;
                        const u32x2 g = *(const u32x2*)(gates + row * ldg + gcol0 + col);
                        f32x4 gv; gv[0] = __uint_as_float(g.x << 16); gv[1] = __uint_as_float(g.x & 0xffff0000u); gv[2] = __uint_as_float(g.y << 16); gv[3] = __uint_as_float(g.y & 0xffff0000u);
                        f32x4 v = acc[ai][bj][m][n] * gv; float* tp = T + row * 1024 + col;
                        if (mode == 0) { *(f32x4*)tp = v; }
                        else if (mode == 1) { *(f32x4*)tp = *(const f32x4*)tp + v; }
                        else { v = v + *(const f32x4*)tp; u32x2 w; w.x = cvt_pk_bf16(v[0], v[1]); w.y = cvt_pk_bf16(v[2], v[3]); *(u32x2*)(GU + row * 1024 + col) = w; } } }
    }
};
}
#define XB_TMO      128
#define XB_XCNT(j)  (256  + 64 * (j))
#define XB_XSUB(j)  (1280 + 64 * (j))
#define XB_XGEN(j)  (2304 + 64 * (j))
#define XB_TOP      3328
#define XB_TOPGEN   3392
#define XCD_BAR_WORDS 3456
#define XB_SPIN_CAP (1u << 18)

__device__ __forceinline__ unsigned xb_ld(unsigned* p)              { return __hip_atomic_load(p, __ATOMIC_RELAXED, __HIP_MEMORY_SCOPE_AGENT); }
__device__ __forceinline__ unsigned xb_add(unsigned* p, unsigned v) { return __hip_atomic_fetch_add(p, v, __ATOMIC_RELAXED, __HIP_MEMORY_SCOPE_AGENT); }
__device__ __forceinline__ unsigned xb_xcc_id() { return (unsigned)__builtin_amdgcn_s_getreg((3 << 11) | 20) & 0xFu; }
#define XB_SPIN(cond, bar) do { unsigned _sp = 0; while (cond) { __builtin_amdgcn_s_sleep(1); \
    if ((++_sp & 255u) == 0u) { if (xb_ld(&(bar)[XB_TMO])) break; if (_sp > XB_SPIN_CAP) { atomicAdd(&(bar)[XB_TMO], 1u); break; } } } } while (0)

struct XcdBarrier {
    unsigned* bar; unsigned x;
    volatile LAS unsigned* st;
};

__device__ __forceinline__ XcdBarrier xcd_barrier_post(unsigned* bar, volatile LAS unsigned* st) {
    XcdBarrier b; b.bar = bar; b.x = xb_xcc_id(); b.st = st;
    if (threadIdx.x == 0) (void)xb_add(&bar[XB_XCNT(b.x)], 1u);
    return b;
}
__device__ __forceinline__ void xcd_barrier_complete(unsigned* bar, unsigned x, unsigned& nloc, unsigned& nx) {
    const unsigned G = gridDim.x * gridDim.y * gridDim.z;
    unsigned sum, cnt, mine, sp = 0u;
    for (;;) {
        sum = 0u; cnt = 0u; mine = 0u;
#pragma unroll
        for (unsigned j = 0; j < 16; ++j) { const unsigned c = xb_ld(&bar[XB_XCNT(j)]); sum += c; cnt += (c > 0u) ? 1u : 0u; mine = (j == x) ? c : mine; }
        if (sum == G) break;
        __builtin_amdgcn_s_sleep(1);
        if ((++sp & 255u) == 0u) { if (xb_ld(&bar[XB_TMO])) break; if (sp > XB_SPIN_CAP) { atomicAdd(&bar[XB_TMO], 1u); break; } }
    }
    nloc = mine > 0u ? mine : 1u; nx = cnt > 0u ? cnt : 1u;
}

__device__ __forceinline__ void xcd_barrier(const XcdBarrier& b) {
    asm volatile("s_waitcnt vmcnt(0)" ::: "memory");
    __syncthreads();
    if (threadIdx.x == 0) {
        unsigned* bar = b.bar;
        __builtin_amdgcn_s_waitcnt(0);
        unsigned nloc = b.st[0], nx = b.st[1];
        if (nloc == 0u) { xcd_barrier_complete(bar, b.x, nloc, nx); b.st[0] = nloc; b.st[1] = nx; }
        const unsigned old = xb_add(&bar[XB_XSUB(b.x)], 1u);
        const unsigned gen = old / nloc;
        if (old + 1u == (gen + 1u) * nloc) {
            __builtin_amdgcn_fence(__ATOMIC_RELEASE, "agent");
            asm volatile("s_waitcnt vmcnt(0)" ::: "memory");
            const unsigned og = xb_add(&bar[XB_TOP], 1u);
            const unsigned tg = og / nx;
            if (og + 1u == (tg + 1u) * nx) xb_add(&bar[XB_TOPGEN], 1u);
            else XB_SPIN(xb_ld(&bar[XB_TOPGEN]) == tg, bar);
            __builtin_amdgcn_fence(__ATOMIC_ACQUIRE, "agent");
            xb_add(&bar[XB_XGEN(b.x)], 1u);
            asm volatile("s_waitcnt vmcnt(0)" ::: "memory");
        } else {
            XB_SPIN(xb_ld(&bar[XB_XGEN(b.x)]) == gen, bar);
            __builtin_amdgcn_fence(__ATOMIC_ACQUIRE, "agent");
            asm volatile("s_waitcnt vmcnt(0)" ::: "memory");
        }
    }
    __syncthreads();
}
constexpr int NWAVES = 8;
constexpr int M = 12288, MP = 8192, DM = 1024, FF = 2816, NL = 2, NGRP = 5, NMOD = 9 * 1024;
constexpr int NKEYS = 8192 + 4 * 1280;
constexpr float ALPHA = 1.41421356237f, LN_EPS = 1e-5f, RMS_EPS = 1e-6f, GN_EPS = 64e-5f;
constexpr float QSCALE = 0.125f * 1.4426950408889634f;
constexpr size_t MiB = 1u << 20;
constexpr size_t WS_CTL = 0, CTL_ZERO_BYTES = 1 * MiB;
constexpr size_t WS_MOD = 1 * MiB;
constexpr size_t WS_LAM = WS_MOD + 512 * 1024;
constexpr size_t WS_LORA = 2 * MiB;
constexpr size_t WS_BON = 3 * MiB;
constexpr size_t WS_WB = 4 * MiB;
constexpr size_t WS_H = 109 * MiB;
constexpr size_t WS_BIG = 133 * MiB;
constexpr size_t WS_END = 352 * MiB;
constexpr size_t WL_W1A = 0, WL_W1B = 5767168, WL_WIN = 8650752, WL_WUP = 16252928, WL_WO = 17825792, WL_W2A = 18874368, WL_W2B = 24641536, WL_SIZE = 27525120;
constexpr int WIN_ATT = 0, WIN_RWKV = 2304, WIN_GATE = 4352, WIN_ROWS = 7424;
constexpr size_t B_ACT = 0, B_Z2 = 66 * MiB;
constexpr size_t B_PQA = 0, B_PQR = 0;
constexpr size_t B_QA = 54 * MiB, B_QB = 66 * MiB, B_KA = 78 * MiB, B_VA = B_KA + 3328 * 1024, B_KB = B_VA + 3328 * 1024, B_VB = B_KB + 13 * MiB;
constexpr size_t B_SR = 111 * MiB, B_SK = 123 * MiB, B_SKK = 135 * MiB, B_SV = 147 * MiB, B_SA0 = 159 * MiB, B_SA1 = 171 * MiB, B_SW0 = 183 * MiB, B_SW1 = 195 * MiB, B_G = 207 * MiB;
constexpr size_t B_OA = 0, B_OB = 12 * MiB, B_OF = 24 * MiB, B_OBW = 36 * MiB, B_OC = 54 * MiB;
constexpr size_t B_GATES = 66 * MiB, B_T = 138 * MiB, B_GU = 186 * MiB, B_Z1 = 0;
static_assert(B_VB + 13 * MiB <= B_SR && B_G + 12 * MiB <= WS_END - WS_BIG && B_GU + 24 * MiB <= WS_END - WS_BIG, "BIG map");
constexpr size_t O_Y = 0, O_NAK = 12582912, O_NAV = 14680064, O_NDK = 16777216, O_NDV = 25165824, O_NST = 33554432, O_TOTAL = 37748736;
constexpr int RING_OFF = 0, RING_BYTES = 131072, LDSCTL_OFF = RING_BYTES, MISC_OFF = LDSCTL_OFF + 320, LDS_BYTES = 147456;
constexpr int CW_TMO = 0, CW_CODE = 1, CW_BAR = 4096;
struct Args { const float* in[32]; float* out; unsigned char* ws; int ph_lo, ph_hi; };
struct Frame {
    LAS unsigned char* lds;
    int tid, lane, wave, G, bid, gw, NGW;
    const Args* a; float* out; unsigned char* ws; unsigned char* big;
};
__device__ __forceinline__ float bflo(unsigned w) { return __uint_as_float(w << 16); }
__device__ __forceinline__ float bfhi(unsigned w) { return __uint_as_float(w & 0xffff0000u); }
__device__ __forceinline__ float bf1(bf16 v) { return __uint_as_float((unsigned)v << 16); }
__device__ __forceinline__ float sigm(float x) { return 1.0f / (1.0f + __expf(-x)); }
__device__ __forceinline__ float wave_sum(float v) {
#pragma unroll
    for (int o = 1; o < 64; o <<= 1) v += __shfl_xor(v, o);
    return v;
}
__device__ __forceinline__ float wave_max(float v) {
#pragma unroll
    for (int o = 1; o < 64; o <<= 1) v = fmaxf(v, __shfl_xor(v, o));
    return v;
}
__device__ __forceinline__ float red16(float v) { v += __shfl_xor(v, 1); v += __shfl_xor(v, 2); v += __shfl_xor(v, 4); v += __shfl_xor(v, 8); return v; }
__device__ __forceinline__ int row_group(int m) { return m < MP ? 0 : 1 + ((m - MP) >> 10); }
__device__ __forceinline__ int key_base(int seq) { return seq < 32 ? seq * 256 : 8192 + (seq - 32) * 1280; }
__device__ __forceinline__ const float* modp(const Frame& F, int l, int g, int i) { return (const float*)(F.ws + WS_MOD) + ((size_t)(l * NGRP + g) * 9 + i) * 1024; }
__device__ __forceinline__ bf16* wlayer(const Frame& F, int l) { return (bf16*)(F.ws + WS_WB) + (size_t)l * WL_SIZE; }

__device__ __forceinline__ void p0_item(const float* Wsrc  , int ldw, int K, bf16* WTrow0  , int kb, bool zero, LAS float* scr, int lane) {
    const int k0 = 64 * kb;
    if (zero) {
#pragma unroll
        for (int j = 0; j < 4; ++j) { const int n = (lane >> 3) + 8 * j; *(GAS v4u*)(WTrow0 + (size_t)n * K + k0 + 8 * (lane & 7)) = (v4u){0u, 0u, 0u, 0u}; }
        return;
    }
#pragma unroll 8
    for (int i = 0; i < 32; ++i) { const int kk = 2 * i + (lane >> 5); scr[kk * 33 + (lane & 31)] = Wsrc[(size_t)(k0 + kk) * ldw + (lane & 31)]; }
    LDS_WAIT(); asm volatile("" ::: "memory");
    const int c = lane & 7;
#pragma unroll
    for (int j = 0; j < 4; ++j) { const int n = (lane >> 3) + 8 * j; const LAS float* s = scr + (8 * c) * 33 + n;
        v4u o; o.x = pk2(s[0 * 33], s[1 * 33]); o.y = pk2(s[2 * 33], s[3 * 33]); o.z = pk2(s[4 * 33], s[5 * 33]); o.w = pk2(s[6 * 33], s[7 * 33]);
        *(GAS v4u*)(WTrow0 + (size_t)n * K + k0 + 8 * c) = o; }
    LDS_WAIT(); asm volatile("" ::: "memory");
}
constexpr int IT_W1A = 16 * 176, IT_W1B = 44 * 32, IT_WIN = 16 * 232, IT_WUP = 3 * 8 * 32, IT_WO = 16 * 32, IT_LAYER = 2 * IT_W1A + 2 * IT_W1B + IT_WIN + IT_WUP + IT_WO;
__device__ __forceinline__ void conv_item(const Frame& F, int it, LAS float* scr) {
    const int l = it / IT_LAYER; int r = it % IT_LAYER; bf16* wl = wlayer(F, l); const int lane = F.lane;
    for (int f = 0; f < 2; ++f) {
        if (r < IT_W1A) { const int kb = r / 176, db = r % 176, tile = db >> 3, half = (db >> 2) & 1, q = db & 3;
            p0_item(F.a->in[13] + (size_t)(l * 2 + f) * 1024 * 5632 + half * 2816 + tile * 128 + q * 32, 5632, 1024, wl + (f ? WL_W2A : WL_W1A) + (size_t)(32 * db) * 1024, kb, false, scr, lane); return; }
        r -= IT_W1A;
        if (r < IT_W1B) { const int kb = r / 32, db = r % 32;
            p0_item(F.a->in[14] + (size_t)(l * 2 + f) * 2816 * 1024 + 32 * db, 1024, 2816, wl + (f ? WL_W2B : WL_W1B) + (size_t)(32 * db) * 2816, kb, false, scr, lane); return; }
        r -= IT_W1B;
    }
    if (r < IT_WIN) { const int kb = r / 232, db = r % 232, row = 32 * db; int src = 0; bool zero = false;
        if (row < WIN_RWKV) src = 3072 + row; else if (row < WIN_GATE) { const int rr = row - WIN_RWKV; if (rr < 1920) src = 5376 + rr; else zero = true; } else src = row - WIN_GATE;
        p0_item(F.a->in[15] + (size_t)l * 1024 * 7296 + src, 7296, 1024, wl + WL_WIN + (size_t)row * 1024, kb, zero, scr, lane); return; }
    r -= IT_WIN;
    if (r < IT_WUP) { const int i = r / 256, r2 = r % 256, kb = r2 / 32, db = r2 % 32;
        p0_item(F.a->in[30] + (size_t)(l * 3 + i) * 512 * 1024 + 32 * db, 1024, 512, wl + WL_WUP + (size_t)i * 524288 + (size_t)(32 * db) * 512, kb, false, scr, lane); return; }
    r -= IT_WUP;
    { const int kb = r / 32, db = r % 32;
      p0_item(F.a->in[31] + (size_t)l * 1024 * 1024 + 32 * db, 1024, 1024, wl + WL_WO + (size_t)(32 * db) * 1024, kb, false, scr, lane); }
}
__device__ __forceinline__ void phase_conv(const Frame& F) {
    LAS float* red = (LAS float*)(F.lds + RING_OFF);
    for (int task = F.bid; task < NL * (NMOD / 64); task += F.G) {
        const int l = task / (NMOD / 64), n = (task % (NMOD / 64)) * 64 + F.lane;
        const float* wm = F.a->in[9] + (size_t)l * 1024 * NMOD + n;
        float acc[NGRP] = {0.f, 0.f, 0.f, 0.f, 0.f};
        const int k0 = F.wave * 128;
#pragma unroll 4
        for (int k = k0; k < k0 + 128; ++k) {
            const float w = wm[(size_t)k * NMOD];
#pragma unroll
            for (int g = 0; g < NGRP; ++g) { const float cv = g == 0 ? F.a->in[8][k] : F.a->in[7][(g - 1) * 1024 + k]; acc[g] += cv * sigm(cv) * w; }
        }
#pragma unroll
        for (int g = 0; g < NGRP; ++g) red[(F.wave * NGRP + g) * 64 + F.lane] = acc[g];
        __syncthreads();
        if (F.wave < NGRP) { float s = F.a->in[10][(size_t)l * NMOD + n];
#pragma unroll
            for (int w = 0; w < 8; ++w) s += red[(w * NGRP + F.wave) * 64 + F.lane];
            ((float*)(F.ws + WS_MOD))[(size_t)(l * NGRP + F.wave) * NMOD + n] = s; }
        __syncthreads();
    }
    LAS float* scr = (LAS float*)(F.lds + RING_OFF + F.wave * 16384);
    for (int it = F.gw; it < NL * IT_LAYER; it += F.NGW) conv_item(F, it, scr);
    bf16* lora = (bf16*)(F.ws + WS_LORA);
    const int gt = F.gw * 64 + F.lane, NT = F.NGW * 64;
    for (int e = gt; e < NL * 196608; e += NT) {
        const int l = e / 196608, r = e % 196608; float v;
        if (r < 65536) { const int d = r >> 15, c = (r >> 6) & 511, rr = r & 63; v = F.a->in[21][((size_t)(l * 2 + d) * 64 + rr) * 512 + c]; }
        else if (r < 131072) { const int r2 = r - 65536, d = r2 >> 15, c = (r2 >> 6) & 511, rr = r2 & 63; v = F.a->in[23][((size_t)(l * 2 + d) * 64 + rr) * 512 + c]; }
        else { const int r2 = r - 131072, c = r2 >> 7, rr = r2 & 127; v = F.a->in[24][((size_t)l * 128 + rr) * 512 + c]; }
        lora[e] = (bf16)f2bf(v);
    }
    if (F.bid == 0 && F.wave == 0) {
        for (int l = 0; l < NL; ++l) { const float* lv = F.a->in[17] + l * 256;
            const float d01 = wave_sum(lv[F.lane] * lv[64 + F.lane]), d23 = wave_sum(lv[128 + F.lane] * lv[192 + F.lane]);
            if (F.lane == 0) ((float*)(F.ws + WS_LAM))[l] = __expf(d01) - __expf(d23) + (0.8f - 0.6f * __expf(-0.3f * (float)l)); }
    }
}
__device__ __forceinline__ void phase_init(const Frame& F) {
    for (int m = F.gw; m < M; m += F.NGW) {
        const float* xr = m < MP ? F.a->in[0] + (size_t)m * DM : F.a->in[1] + (size_t)(m - MP) * DM;
        const int g = row_group(m); const float* sh = modp(F, 0, g, 0); const float* sc = modp(F, 0, g, 1);
        float* X = F.out + (size_t)m * DM; bf16* H = (bf16*)(F.ws + WS_H) + (size_t)m * DM;
#pragma unroll
        for (int j = 0; j < 4; ++j) { const int c = 4 * F.lane + 256 * j; const f32x4 v = *(const f32x4*)(xr + c), s1 = *(const f32x4*)(sc + c), s0 = *(const f32x4*)(sh + c);
            *(f32x4*)(X + c) = v; const f32x4 h = v * (s1 + 1.0f) + s0;
            unsigned long long o = (unsigned long long)pk2(h[0], h[1]) | ((unsigned long long)pk2(h[2], h[3]) << 32); *(unsigned long long*)(H + c) = o; }
    }
}
__device__ __forceinline__ void phase_ln(const Frame& F, int l, int s, const float* Z) {
    const float gs = (s == 1) ? 1.0f : 0.5f; const int l2 = s < 2 ? l : l + 1, s2 = s < 2 ? s + 1 : 0;
    const float* lng = F.a->in[11] + (size_t)(l * 3 + s) * DM; const float* lnb = F.a->in[12] + (size_t)(l * 3 + s) * DM;
    for (int m = F.gw; m < M; m += F.NGW) {
        const int g = row_group(m); const float* gate = modp(F, l, g, 3 * s + 2);
        float* X = F.out + (size_t)m * DM; const float* zr = Z + (size_t)m * DM; bf16* H = (bf16*)(F.ws + WS_H) + (size_t)m * DM;
        f32x4 v[4]; float sum = 0.f;
#pragma unroll
        for (int j = 0; j < 4; ++j) { const int c = 4 * F.lane + 256 * j; const f32x4 x = *(const f32x4*)(X + c), z = *(const f32x4*)(zr + c), gt = *(const f32x4*)(gate + c);
            v[j] = x * ALPHA + gt * z * gs; sum += (v[j][0] + v[j][1]) + (v[j][2] + v[j][3]); }
        const float mean = wave_sum(sum) * (1.0f / DM); float s2q = 0.f;
#pragma unroll
        for (int j = 0; j < 4; ++j) { v[j] = v[j] - mean; s2q += (v[j][0] * v[j][0] + v[j][1] * v[j][1]) + (v[j][2] * v[j][2] + v[j][3] * v[j][3]); }
        const float rstd = 1.0f / sqrtf(wave_sum(s2q) * (1.0f / DM) + LN_EPS);
#pragma unroll
        for (int j = 0; j < 4; ++j) { const int c = 4 * F.lane + 256 * j; const f32x4 xn = v[j] * rstd * *(const f32x4*)(lng + c) + *(const f32x4*)(lnb + c);
            *(f32x4*)(X + c) = xn;
            if (l2 < NL) { const f32x4 s1 = *(const f32x4*)(modp(F, l2, g, 3 * s2 + 1) + c), s0 = *(const f32x4*)(modp(F, l2, g, 3 * s2) + c); const f32x4 h = xn * (s1 + 1.0f) + s0;
                unsigned long long o = (unsigned long long)pk2(h[0], h[1]) | ((unsigned long long)pk2(h[2], h[3]) << 32); *(unsigned long long*)(H + c) = o; } }
    }
}
__device__ __forceinline__ float rope1(float x, int lane, int t) {
    const int i = lane & 15; const float pos = (float)((lane & 32) ? (t & 63) : (t >> 6));
    const float ang = pos * exp2f(-(float)i * 0.8304820237f);
    const float cs = cosf(ang), sn = sinf(ang); const float p = __shfl_xor(x, 16);
    return (lane & 16) ? (x * cs + p * sn) : (x * cs - p * sn);
}
__device__ __forceinline__ void phase_attprep(const Frame& F, int l) {
    const bf16* PQA = (const bf16*)(F.big + B_PQA);
    bf16* QA = (bf16*)(F.big + B_QA); bf16* QB = (bf16*)(F.big + B_QB); bf16* KA = (bf16*)(F.big + B_KA); bf16* VA = (bf16*)(F.big + B_VA); bf16* KB = (bf16*)(F.big + B_KB); bf16* VB = (bf16*)(F.big + B_VB);
    const int lane = F.lane; const float g0 = F.a->in[16][(l * 2 + 0) * 64 + lane], g1 = F.a->in[16][(l * 2 + 1) * 64 + lane];
    for (int m = F.gw; m < M; m += F.NGW) {
        const bool smp = m >= MP; const int seq = smp ? 32 + ((m - MP) >> 10) : (m >> 8), t = smp ? ((m - MP) & 1023) : (m & 255);
        const size_t key = (size_t)key_base(seq) + t; const bf16* pr = PQA + (size_t)m * 2304;
#pragma unroll
        for (int h = 0; h < 8; ++h) { const float x = bf1(pr[h * 64 + lane]); float xn = x * rsqrtf(wave_sum(x * x) * (1.0f / 64.0f) + RMS_EPS) * g0; if (smp) xn = rope1(xn, lane, t);
            QA[(size_t)m * 512 + h * 64 + lane] = (bf16)f2bf(xn * QSCALE); }
#pragma unroll
        for (int h = 0; h < 2; ++h) { const float x = bf1(pr[512 + h * 64 + lane]); float xn = x * rsqrtf(wave_sum(x * x) * (1.0f / 64.0f) + RMS_EPS) * g1; const float v = bf1(pr[640 + h * 64 + lane]);
            if (!smp) { const size_t o = ((size_t)((seq * 2 + l) * 2 + h) * 256 + t) * 64 + lane; F.out[O_NAK + o] = xn; F.out[O_NAV + o] = v; } else xn = rope1(xn, lane, t);
            KA[((size_t)h * NKEYS + key) * 64 + lane] = (bf16)f2bf(xn); VA[((size_t)h * NKEYS + key) * 64 + lane] = (bf16)f2bf(v); }
#pragma unroll
        for (int hc = 0; hc < 8; ++hc) { const int h = hc >> 1, c = hc & 1;
            float q = bf1(pr[768 + hc * 64 + lane]); float k = bf1(pr[1280 + hc * 64 + lane]); const float v = bf1(pr[1792 + hc * 64 + lane]);
            if (!smp) { const size_t o = ((size_t)((seq * 2 + l) * 4 + h) * 256 + t) * 128 + c * 64 + lane; F.out[O_NDK + o] = k; F.out[O_NDV + o] = v; } else { q = rope1(q, lane, t); k = rope1(k, lane, t); }
            QB[(size_t)m * 512 + hc * 64 + lane] = (bf16)f2bf(q * QSCALE);
            KB[((size_t)(h * 2 + c) * NKEYS + key) * 64 + lane] = (bf16)f2bf(k);
            VB[((size_t)h * NKEYS + key) * 128 + c * 64 + lane] = (bf16)f2bf(v); }
    }
    for (int it = F.gw; it < 4 * 256; it += F.NGW) { const int b = it >> 8, p = it & 255; const size_t key = (size_t)key_base(32 + b) + 1024 + p;
#pragma unroll
        for (int h = 0; h < 2; ++h) { const size_t s = ((size_t)((b * 2 + l) * 2 + h) * 256 + p) * 64 + lane;
            KA[((size_t)h * NKEYS + key) * 64 + lane] = (bf16)f2bf(F.a->in[2][s]); VA[((size_t)h * NKEYS + key) * 64 + lane] = (bf16)f2bf(F.a->in[3][s]); }
#pragma unroll
        for (int hc = 0; hc < 8; ++hc) { const int h = hc >> 1, c = hc & 1; const size_t s = ((size_t)((b * 2 + l) * 4 + h) * 256 + p) * 128 + c * 64 + lane;
            KB[((size_t)(h * 2 + c) * NKEYS + key) * 64 + lane] = (bf16)f2bf(F.a->in[4][s]); VB[((size_t)h * NKEYS + key) * 128 + c * 64 + lane] = (bf16)f2bf(F.a->in[5][s]); }
    }
}
struct RwkvBufs { bf16 *SR, *SK, *SKK, *SV, *SA0, *SA1, *G; _Float16 *SW0, *SW1; float* BON; };
__device__ __forceinline__ RwkvBufs rwkv_bufs(const Frame& F) {
    RwkvBufs b; b.SR = (bf16*)(F.big + B_SR); b.SK = (bf16*)(F.big + B_SK); b.SKK = (bf16*)(F.big + B_SKK); b.SV = (bf16*)(F.big + B_SV); b.SA0 = (bf16*)(F.big + B_SA0); b.SA1 = (bf16*)(F.big + B_SA1);
    b.G = (bf16*)(F.big + B_G); b.SW0 = (_Float16*)(F.big + B_SW0); b.SW1 = (_Float16*)(F.big + B_SW1); b.BON = (float*)(F.ws + WS_BON); return b;
}
__device__ __forceinline__ void mixed8(const bf16* PQR, const float* mu, int m, int cb, bool hp, bool hn, float (&o)[8]) {
    const v4u cur = *(const v4u*)(PQR + (size_t)m * 2048 + cb); v4u pv = {0u, 0u, 0u, 0u}, nv = {0u, 0u, 0u, 0u};
    if (hp) pv = *(const v4u*)(PQR + (size_t)(m - 1) * 2048 + cb);
    if (hn) nv = *(const v4u*)(PQR + (size_t)(m + 1) * 2048 + cb);
    const f32x4 m0 = *(const f32x4*)(mu + cb), m1 = *(const f32x4*)(mu + cb + 4);
#pragma unroll
    for (int w = 0; w < 4; ++w) { const float c0 = bflo(cur[w]), c1 = bfhi(cur[w]); const float mua = w < 2 ? m0[2 * w] : m1[2 * w - 4], mub = w < 2 ? m0[2 * w + 1] : m1[2 * w - 3];
        o[2 * w] = c0 + mua * (0.5f * (bflo(pv[w]) + bflo(nv[w])) - c0); o[2 * w + 1] = c1 + mub * (0.5f * (bfhi(pv[w]) + bfhi(nv[w])) - c1); }
}
__device__ __forceinline__ float mixed1(const bf16* PQR, float mu, int m, int c, bool hp, bool hn) {
    const float cur = bf1(PQR[(size_t)m * 2048 + c]); const float p = hp ? bf1(PQR[(size_t)(m - 1) * 2048 + c]) : 0.f, n = hn ? bf1(PQR[(size_t)(m + 1) * 2048 + c]) : 0.f;
    return cur + mu * (0.5f * (p + n) - cur);
}
__device__ __forceinline__ bf16x8 pack8(const float (&v)[8]) {
    v4u w; w.x = pk2(v[0], v[1]); w.y = pk2(v[2], v[3]); w.z = pk2(v[4], v[5]); w.w = pk2(v[6], v[7]); return __builtin_bit_cast(bf16x8, w);
}
__device__ __forceinline__ void phase_rwkvprep(const Frame& F, int l) {
    const bf16* PQR = (const bf16*)(F.big + B_PQR); const RwkvBufs B = rwkv_bufs(F);
    const float* mu = F.a->in[19] + (size_t)l * 1920; const bf16* lora = (const bf16*)(F.ws + WS_LORA) + (size_t)l * 196608;
    const bf16* W2T = lora; const bf16* A2T = lora + 65536; const bf16* G2T = lora + 131072;
    const float* w0 = F.a->in[20] + (size_t)l * 1024; const float* a0p = F.a->in[22] + (size_t)l * 1024;
    const float* kkp = F.a->in[25] + (size_t)l * 512; const float* kap = F.a->in[26] + (size_t)l * 512; const float* rkp = F.a->in[27] + (size_t)l * 512;
    const int lane = F.lane, col = lane & 15, q = lane >> 4;
    for (int task = F.gw; task < M / 16; task += F.NGW) {
        const int tok0 = task * 16;
        bf16x8 Aw[2][2], Aa[2][2];
        { const int m = tok0 + col; const bool smp = m >= MP; const int t = smp ? ((m - MP) & 1023) : (m & 255), T = smp ? 1024 : 256; const bool hp = t > 0, hn = t < T - 1; float v[8];
#pragma unroll
          for (int d = 0; d < 2; ++d)
#pragma unroll
              for (int s = 0; s < 2; ++s) {
                  mixed8(PQR, mu, m, 1536 + d * 64 + 32 * s + 8 * q, hp, hn, v);
#pragma unroll
                  for (int j = 0; j < 8; ++j) v[j] = 1.0f - 2.0f / (1.0f + __expf(2.0f * v[j]));
                  Aw[d][s] = pack8(v);
                  mixed8(PQR, mu, m, 1664 + d * 64 + 32 * s + 8 * q, hp, hn, v); Aa[d][s] = pack8(v); }
 }
        bool hp4[4], hn4[4];
#pragma unroll
        for (int j = 0; j < 4; ++j) { const int m = tok0 + 4 * q + j; const bool smp = m >= MP; const int t = smp ? ((m - MP) & 1023) : (m & 255), T = smp ? 1024 : 256; hp4[j] = t > 0; hn4[j] = t < T - 1; }
        for (int h = 0; h < 8; ++h) {
            float ss[4] = {0.f, 0.f, 0.f, 0.f}, bs[4] = {0.f, 0.f, 0.f, 0.f};
#pragma unroll 1
            for (int cbi = 0; cbi < 4; ++cbi) {
                const int c = 64 * h + 16 * cbi + col;
                f32x4 accw[2], acca[2];
#pragma unroll
                for (int d = 0; d < 2; ++d) { accw[d] = (f32x4){0.f, 0.f, 0.f, 0.f}; acca[d] = (f32x4){0.f, 0.f, 0.f, 0.f};
#pragma unroll
                    for (int s = 0; s < 2; ++s) {
                        const bf16x8 bw = *(const bf16x8*)(W2T + ((size_t)d * 512 + c) * 64 + 32 * s + 8 * q), ba = *(const bf16x8*)(A2T + ((size_t)d * 512 + c) * 64 + 32 * s + 8 * q);
                        accw[d] = __builtin_amdgcn_mfma_f32_16x16x32_bf16(Aw[d][s], bw, accw[d], 0, 0, 0);
                        acca[d] = __builtin_amdgcn_mfma_f32_16x16x32_bf16(Aa[d][s], ba, acca[d], 0, 0, 0); } }
                const float mur = mu[c], muk = mu[512 + c], muv = mu[1024 + c], w00 = w0[c], w01 = w0[512 + c], a00 = a0p[c], a01 = a0p[512 + c], kkc = kkp[c], kac = kap[c], rkc = rkp[c];
#pragma unroll
                for (int j = 0; j < 4; ++j) { const int m = tok0 + 4 * q + j; const size_t o = (size_t)m * 512 + c;
                    const float r = mixed1(PQR, mur, m, c, hp4[j], hn4[j]), k = mixed1(PQR, muk, m, 512 + c, hp4[j], hn4[j]), v = mixed1(PQR, muv, m, 1024 + c, hp4[j], hn4[j]);
                    const float dec0 = __expf(-0.6065306597f * sigm(w00 + accw[0][j])), dec1 = __expf(-0.6065306597f * sigm(w01 + accw[1][j]));
                    const float av0 = sigm(a00 + acca[0][j]), av1 = sigm(a01 + acca[1][j]);
                    const float kr = bf1((bf16)f2bf(k * kkc)); ss[j] += kr * kr; B.SKK[o] = (bf16)f2bf(kr);
                    const float kh0 = k * (1.0f + (av0 - 1.0f) * kac), kh1 = k * (1.0f + (av1 - 1.0f) * kac); bs[j] += r * (kh0 + kh1) * rkc;
                    B.SR[o] = (bf16)f2bf(r); B.SK[o] = (bf16)f2bf(k); B.SV[o] = (bf16)f2bf(v); B.SA0[o] = (bf16)f2bf(av0); B.SA1[o] = (bf16)f2bf(av1);
                    B.SW0[o] = (_Float16)dec0; B.SW1[o] = (_Float16)dec1; }
            }
#pragma unroll
            for (int j = 0; j < 4; ++j) { const float rn = rsqrtf(red16(ss[j]) + 1e-12f); const float bsum = red16(bs[j]); const int m = tok0 + 4 * q + j;
#pragma unroll
                for (int cbi = 0; cbi < 4; ++cbi) { bf16* pk = B.SKK + (size_t)m * 512 + 64 * h + 16 * cbi + col; *pk = (bf16)f2bf(bf1(*pk) * rn); }
                if (col == 0) B.BON[(size_t)m * 8 + h] = bsum; }
        }
        { bf16x8 Ag[4]; { const int m = tok0 + col; const bool smp = m >= MP; const int t = smp ? ((m - MP) & 1023) : (m & 255), T = smp ? 1024 : 256; const bool hp = t > 0, hn = t < T - 1; float v[8];
#pragma unroll
            for (int s = 0; s < 4; ++s) { mixed8(PQR, mu, m, 1792 + 32 * s + 8 * q, hp, hn, v);
#pragma unroll
                for (int j = 0; j < 8; ++j) v[j] = sigm(v[j]);
                Ag[s] = pack8(v); } }
#pragma unroll 2
          for (int cb = 0; cb < 32; ++cb) { const int c = 16 * cb + col; f32x4 accg = {0.f, 0.f, 0.f, 0.f};
#pragma unroll
              for (int s = 0; s < 4; ++s) { const bf16x8 bg = *(const bf16x8*)(G2T + (size_t)c * 128 + 32 * s + 8 * q); accg = __builtin_amdgcn_mfma_f32_16x16x32_bf16(Ag[s], bg, accg, 0, 0, 0); }
#pragma unroll
              for (int j = 0; j < 4; ++j) B.G[(size_t)(tok0 + 4 * q + j) * 512 + c] = (bf16)f2bf(accg[j]); } }
    }
}
template <int DV> __device__ __forceinline__ void attn_row(const bf16* q, const bf16* K, const bf16* V, int nk, int lane, float (&O)[DV / 64], float& lsum) {
    float qf[64];
#pragma unroll
    for (int i = 0; i < 8; ++i) { const v4u w = *(const v4u*)(q + 8 * i);
#pragma unroll
        for (int j = 0; j < 4; ++j) { qf[8 * i + 2 * j] = bflo(w[j]); qf[8 * i + 2 * j + 1] = bfhi(w[j]); } }
    float mrun = -INFINITY; lsum = 0.f;
#pragma unroll
    for (int j = 0; j < DV / 64; ++j) O[j] = 0.f;
    for (int kt = 0; kt < nk; kt += 64) {
        const bf16* kr = K + (size_t)(kt + lane) * 64; float s = 0.f;
#pragma unroll
        for (int i = 0; i < 8; ++i) { const v4u w = *(const v4u*)(kr + 8 * i);
#pragma unroll
            for (int j = 0; j < 4; ++j) { s += qf[8 * i + 2 * j] * bflo(w[j]); s += qf[8 * i + 2 * j + 1] * bfhi(w[j]); } }
        const float mnew = fmaxf(mrun, wave_max(s)); const float p = exp2f(s - mnew), corr = exp2f(mrun - mnew);
        lsum = lsum * corr + wave_sum(p); mrun = mnew;
#pragma unroll
        for (int j = 0; j < DV / 64; ++j) O[j] *= corr;
        const bf16* vr = V + (size_t)kt * DV + lane;
#pragma unroll 16
        for (int kk = 0; kk < 64; ++kk) { const float pk = __shfl(p, kk);
#pragma unroll
            for (int j = 0; j < DV / 64; ++j) O[j] += pk * bf1(vr[(size_t)kk * DV + 64 * j]); }
    }
}
__device__ __forceinline__ void phase_attn_naive(const Frame& F, int l) {
    const bf16* QA = (const bf16*)(F.big + B_QA); const bf16* QB = (const bf16*)(F.big + B_QB); const bf16* KA = (const bf16*)(F.big + B_KA); const bf16* VA = (const bf16*)(F.big + B_VA);
    const bf16* KB = (const bf16*)(F.big + B_KB); const bf16* VB = (const bf16*)(F.big + B_VB); bf16* OA = (bf16*)(F.big + B_OA); bf16* OB = (bf16*)(F.big + B_OB);
    const float lam = ((const float*)(F.ws + WS_LAM))[l]; const float lam_init = 0.8f - 0.6f * __expf(-0.3f * (float)l);
    const int lane = F.lane;
    for (int task = F.gw; task < M * 12; task += F.NGW) {
        const int m = M - 1 - task / 12, item = task % 12;
        const bool smp = m >= MP; const int seq = smp ? 32 + ((m - MP) >> 10) : (m >> 8); const int nk = smp ? 1280 : 256; const size_t kb = key_base(seq);
        if (item < 8) { float O[1], ls; attn_row<64>(QA + (size_t)m * 512 + item * 64, KA + ((size_t)(item >> 2) * NKEYS + kb) * 64, VA + ((size_t)(item >> 2) * NKEYS + kb) * 64, nk, lane, O, ls);
            OA[(size_t)m * 512 + item * 64 + lane] = (bf16)f2bf(O[0] / ls); }
        else { const int h = item - 8; float O1[2], O2[2], l1, l2;
            attn_row<128>(QB + (size_t)m * 512 + h * 128, KB + ((size_t)(h * 2 + 0) * NKEYS + kb) * 64, VB + ((size_t)h * NKEYS + kb) * 128, nk, lane, O1, l1);
            attn_row<128>(QB + (size_t)m * 512 + h * 128 + 64, KB + ((size_t)(h * 2 + 1) * NKEYS + kb) * 64, VB + ((size_t)h * NKEYS + kb) * 128, nk, lane, O2, l2);
            const float o0 = O1[0] / l1 - lam * O2[0] / l2, o1 = O1[1] / l1 - lam * O2[1] / l2;
            const float rn = rsqrtf(wave_sum(o0 * o0 + o1 * o1) * (1.0f / 128.0f) + RMS_EPS) * (1.0f - lam_init);
            const float* sg = F.a->in[18] + (size_t)l * 128;
            OB[(size_t)m * 512 + h * 128 + lane] = (bf16)f2bf(o0 * rn * sg[lane]); OB[(size_t)m * 512 + h * 128 + 64 + lane] = (bf16)f2bf(o1 * rn * sg[64 + lane]); }
    }
}
__device__ __forceinline__ void unpack4(unsigned long long w, float (&o)[4]) { const unsigned lo = (unsigned)w, hi = (unsigned)(w >> 32); o[0] = bflo(lo); o[1] = bfhi(lo); o[2] = bflo(hi); o[3] = bfhi(hi); }
__device__ __forceinline__ void phase_scan(const Frame& F, int l) {
    const RwkvBufs B = rwkv_bufs(F); bf16* OFW = (bf16*)(F.big + B_OF); bf16* OBW = (bf16*)(F.big + B_OBW);
    const int lane = F.lane, i = lane & 15, rl = lane >> 4;
    for (int task = F.gw; task < 1024 + 8192; task += F.NGW) {
        const bool smp = task < 1024; const int tt = smp ? task : task - 1024; const int sq = tt >> 8, h = (tt >> 5) & 7, dir = (tt >> 4) & 1, rg = tt & 15;
        const int T = smp ? 1024 : 256, m0 = smp ? MP + 1024 * sq : 256 * sq, row = 4 * rg + rl;
        float S[4] = {0.f, 0.f, 0.f, 0.f};
        if (smp) { const f32x4 s0 = *(const f32x4*)(F.a->in[6] + ((size_t)(((sq * 2 + l) * 2 + dir) * 8 + h) * 64 + row) * 64 + 4 * i); S[0] = s0[0]; S[1] = s0[1]; S[2] = s0[2]; S[3] = s0[3]; }
        const f32x4 ka4 = *(const f32x4*)(F.a->in[26] + (size_t)l * 512 + h * 64 + 4 * i);
        const bf16* SA = dir ? B.SA1 : B.SA0; const _Float16* SW = dir ? B.SW1 : B.SW0; bf16* OUT = dir ? OBW : OFW;
        for (int st = 0; st < T; ++st) {
            const int t = dir ? T - 1 - st : st; const size_t o = (size_t)(m0 + t) * 512 + h * 64;
            float r[4], k[4], kk[4], a[4], w[4];
            unpack4(*(const unsigned long long*)(B.SR + o + 4 * i), r); unpack4(*(const unsigned long long*)(B.SK + o + 4 * i), k); unpack4(*(const unsigned long long*)(B.SKK + o + 4 * i), kk);
            unpack4(*(const unsigned long long*)(SA + o + 4 * i), a);
            { typedef _Float16 h4 __attribute__((ext_vector_type(4))); const h4 wv = *(const h4*)(SW + o + 4 * i); w[0] = (float)wv[0]; w[1] = (float)wv[1]; w[2] = (float)wv[2]; w[3] = (float)wv[3]; }
            const float vv = bf1(B.SV[o + row]);
            float sa = 0.f;
#pragma unroll
            for (int c = 0; c < 4; ++c) sa -= S[c] * kk[c];
            sa = red16(sa);
            float ov = 0.f;
#pragma unroll
            for (int c = 0; c < 4; ++c) { const float kh = k[c] * (1.0f + (a[c] - 1.0f) * ka4[c]); S[c] = S[c] * w[c] + sa * (kk[c] * a[c]) + vv * kh; ov += S[c] * r[c]; }
            ov = red16(ov);
            if (i == 0) OUT[o + row] = (bf16)f2bf(ov);
        }
        if (!smp) *(f32x4*)(F.out + O_NST + ((size_t)(((sq * 2 + l) * 2 + dir) * 8 + h) * 64 + row) * 64 + 4 * i) = (f32x4){S[0], S[1], S[2], S[3]};
    }
}
__device__ __forceinline__ void phase_rwkvpost(const Frame& F, int l) {
    const RwkvBufs B = rwkv_bufs(F); const bf16* OFW = (const bf16*)(F.big + B_OF); const bf16* OBW = (const bf16*)(F.big + B_OBW); bf16* OC = (bf16*)(F.big + B_OC);
    const int lane = F.lane; const float* gng = F.a->in[28] + (size_t)l * 512 + 8 * lane; const float* gnb = F.a->in[29] + (size_t)l * 512 + 8 * lane;
    for (int m = F.gw; m < M; m += F.NGW) {
        const size_t o = (size_t)m * 512 + 8 * lane;
        const v4u a = *(const v4u*)(OFW + o), b = *(const v4u*)(OBW + o), vv = *(const v4u*)(B.SV + o), gg = *(const v4u*)(B.G + o);
        float x[8]; float s = 0.f;
#pragma unroll
        for (int j = 0; j < 4; ++j) { x[2 * j] = bflo(a[j]) + bflo(b[j]); x[2 * j + 1] = bfhi(a[j]) + bfhi(b[j]); s += x[2 * j] + x[2 * j + 1]; }
        s += __shfl_xor(s, 1); s += __shfl_xor(s, 2); s += __shfl_xor(s, 4); const float mean = s * (1.0f / 64.0f); float q = 0.f;
#pragma unroll
        for (int j = 0; j < 8; ++j) { x[j] -= mean; q += x[j] * x[j]; }
        q += __shfl_xor(q, 1); q += __shfl_xor(q, 2); q += __shfl_xor(q, 4); const float rstd = rsqrtf(q * (1.0f / 64.0f) + GN_EPS);
        const float bon = B.BON[(size_t)m * 8 + (lane >> 3)]; float y[8];
#pragma unroll
        for (int j = 0; j < 4; ++j) { const float v0 = bflo(vv[j]), v1 = bfhi(vv[j]), g0 = bflo(gg[j]), g1 = bfhi(gg[j]);
            y[2 * j] = (x[2 * j] * rstd * gng[2 * j] + gnb[2 * j] + bon * v0) * g0; y[2 * j + 1] = (x[2 * j + 1] * rstd * gng[2 * j + 1] + gnb[2 * j + 1] + bon * v1) * g1; }
        v4u w; w.x = pk2(y[0], y[1]); w.y = pk2(y[2], y[3]); w.z = pk2(y[4], y[5]); w.w = pk2(y[6], y[7]); *(v4u*)(OC + o) = w;
    }
}
constexpr int PH_PER_LAYER = 16, N_PHASES = 2 + NL * PH_PER_LAYER;
template <class Epi> __device__ __forceinline__ void run_gemm(const Frame& F, const bf16* A, const bf16* Bt, int N, int K, const Epi& E) {
    pg8::Gemm g{A, Bt, M, N, K}; pg8::StaticOrder S; S.init(M, N, F.G, F.bid);
    pg8::gemm_phase<Epi, pg8::StaticOrder, true, true>(F.lds + RING_OFF, g, S, E);
}
#ifndef PHMASK
#define PHMASK 0xffff
#endif
#define PHON(k) ((PHMASK >> (k)) & 1)
__device__ __forceinline__ void run_phase(const Frame& F, int ph) {
    if (ph == 0) { if (PHON(0)) phase_conv(F); return; }
    if (ph == 1) { if (PHON(1)) phase_init(F); return; }
    const int l = (ph - 2) / PH_PER_LAYER, s = (ph - 2) % PH_PER_LAYER;
    bf16* wl = wlayer(F, l); const bf16* H = (const bf16*)(F.ws + WS_H);
    if (PHON(2) && (s == 0 || s == 13)) { pg8::EpiSwiglu E{(bf16*)(F.big + B_ACT), FF}; run_gemm(F, H, wl + (s ? WL_W2A : WL_W1A), 2 * FF, DM, E); }
    else if (PHON(3) && (s == 1 || s == 11 || s == 14)) {
        const bf16* A = s == 11 ? (const bf16*)(F.big + B_GU) : (const bf16*)(F.big + B_ACT); const int K = s == 11 ? DM : FF;
        const bf16* Bt = wl + (s == 1 ? WL_W1B : s == 11 ? WL_WO : WL_W2B); pg8::EpiF32 E{(float*)(F.big + (s == 11 ? B_Z1 : B_Z2)), DM}; run_gemm(F, A, Bt, DM, K, E); }
    else if (PHON(4) && (s == 2 || s == 12 || s == 15)) { phase_ln(F, l, s == 2 ? 0 : s == 12 ? 1 : 2, (const float*)(F.big + (s == 12 ? B_Z1 : B_Z2))); }
    else if (PHON(5) && (s == 3 || s == 5 || s == 9)) {
        const int r0 = s == 3 ? WIN_ATT : s == 5 ? WIN_RWKV : WIN_GATE, N = s == 3 ? 2304 : s == 5 ? 2048 : 3072;
        pg8::EpiBf E{(bf16*)(F.big + (s == 3 ? B_PQA : s == 5 ? B_PQR : B_GATES)), N, s == 9 ? 1 : 0}; run_gemm(F, H, wl + WL_WIN + (size_t)r0 * DM, N, DM, E); }
    else if (PHON(6) && s == 4) phase_attprep(F, l);
    else if (PHON(7) && s == 6) phase_rwkvprep(F, l);
    else if (s == 7) { if (PHON(8)) phase_scan(F, l); if (PHON(9)) phase_attn_naive(F, l); }
    else if (PHON(10) && s == 8) phase_rwkvpost(F, l);
    else if (PHON(11) && s == 10) {
        for (int i = 0; i < 3; ++i) { const bf16* A = (const bf16*)(F.big + (i == 0 ? B_OA : i == 1 ? B_OB : B_OC));
            pg8::EpiUp E{(const bf16*)(F.big + B_GATES), 3072, i * 1024, (float*)(F.big + B_T), (bf16*)(F.big + B_GU), i}; run_gemm(F, A, wl + WL_WUP + (size_t)i * 524288, DM, 512, E); } }
}
__global__ void __launch_bounds__(NWAVES * 64, 2) fwd(Args args) {
    extern __shared__ __attribute__((aligned(16))) unsigned char lds[];
    Frame F;
    F.lds = (LAS unsigned char*)lds; F.tid = threadIdx.x; F.lane = F.tid & 63; F.wave = __builtin_amdgcn_readfirstlane(F.tid >> 6);
    F.G = gridDim.x; F.bid = blockIdx.x; F.gw = F.bid * NWAVES + F.wave; F.NGW = F.G * NWAVES;
    F.a = &args;
    F.out = args.out; F.ws = args.ws; F.big = args.ws + WS_BIG;
    for (int u = F.tid; u < (LDS_BYTES - LDSCTL_OFF) / 4; u += NWAVES * 64) ((LAS unsigned*)(F.lds + LDSCTL_OFF))[u] = 0u;
    __syncthreads();
    const int lo = args.ph_lo, hi = args.ph_hi;
    XcdBarrier bar; bar.bar = (unsigned*)(args.ws + WS_CTL) + CW_BAR; bar.x = 0; bar.st = nullptr;
    if (hi - lo > 1) bar = xcd_barrier_post((unsigned*)(args.ws + WS_CTL) + CW_BAR, (volatile LAS unsigned*)(F.lds + MISC_OFF) + 8);
    for (int ph = lo; ph < hi; ++ph) {
        Frame FL = F;
        asm volatile("" : "+s"(FL.ws), "+s"(FL.big), "+s"(FL.out), "+v"(FL.lane), "+v"(FL.tid));
        run_phase(FL, ph);
        if (ph + 1 < hi) xcd_barrier(bar);
    }
}
extern "C" void kernel_launch(void* const* d_in, const int* in_sizes, int n_in, void* d_out, int out_size, void* d_ws, size_t ws_size, hipStream_t stream) {
    static int grid = 0;
    if (grid == 0) {
        if (n_in != 32 || out_size != (int)O_TOTAL || ws_size < WS_END) { fprintf(stderr, "kernel_launch: unexpected problem: n_in %d out %d ws %zu (need %zu)\n", n_in, out_size, ws_size, (size_t)WS_END); grid = -1; return; }
        int dev = 0, cus = 0, per_cu = 0;
        if (hipGetDevice(&dev) != hipSuccess || hipDeviceGetAttribute(&cus, hipDeviceAttributeMultiprocessorCount, dev) != hipSuccess) { grid = -1; return; }
        if (hipFuncSetAttribute((const void*)fwd, hipFuncAttributeMaxDynamicSharedMemorySize, LDS_BYTES) != hipSuccess) { fprintf(stderr, "kernel_launch: hipFuncSetAttribute failed\n"); grid = -1; return; }
        if (hipOccupancyMaxActiveBlocksPerMultiprocessor(&per_cu, (const void*)fwd, NWAVES * 64, LDS_BYTES) != hipSuccess || per_cu < 1) { fprintf(stderr, "kernel_launch: occupancy query says %d blocks per CU\n", per_cu); (void)hipGetLastError(); per_cu = 1; }
        grid = cus;
        if (grid > 256) grid = 256;
    }
    if (grid < 0) return;
    (void)hipMemsetAsync((char*)d_ws + WS_CTL, 0, CTL_ZERO_BYTES, stream);
    Args a{};
    for (int i = 0; i < 32; ++i) a.in[i] = (const float*)d_in[i];
    a.out = (float*)d_out; a.ws = (unsigned char*)d_ws;
#if MK_ONE_LAUNCH
    a.ph_lo = 0; a.ph_hi = N_PHASES;
    hipLaunchKernelGGL(fwd, dim3(grid), dim3(NWAVES * 64), LDS_BYTES, stream, a);
#else
    for (int ph = 0; ph < N_PHASES; ++ph) { a.ph_lo = ph; a.ph_hi = ph + 1; hipLaunchKernelGGL(fwd, dim3(grid), dim3(NWAVES * 64), LDS_BYTES, stream, a); }
#endif
}
```

```cpp
#include <hip/hip_runtime.h>
#include <cstdio>
#include <cstdint>
#ifndef MK_ONE_LAUNCH
#define MK_ONE_LAUNCH 1
#endif
#ifndef MK_NAIVE_MIXER
#define MK_NAIVE_MIXER 0
#endif
#define GAS __attribute__((address_space(1)))
#define LAS __attribute__((address_space(3)))
typedef unsigned short bf16;
typedef unsigned v4u __attribute__((ext_vector_type(4)));
typedef float f32x4 __attribute__((ext_vector_type(4)));
typedef short bf16x8 __attribute__((ext_vector_type(8)));
typedef GAS unsigned gu32;
typedef GAS unsigned long long gu64;
#define RLX_AGENT __ATOMIC_RELAXED, __HIP_MEMORY_SCOPE_AGENT
#define LDS_WAIT() asm volatile("s_waitcnt lgkmcnt(0)" ::: "memory")
#define VM_WAIT() asm volatile("s_waitcnt vmcnt(0)" ::: "memory")
__device__ __forceinline__ unsigned long long rt() { return __builtin_amdgcn_s_memrealtime(); }
__device__ __forceinline__ unsigned f2bf(float f) { return __builtin_bit_cast(unsigned short, (__bf16)f); }
typedef float f32x2_pk __attribute__((ext_vector_type(2))); typedef __bf16 bf16x2_pk __attribute__((ext_vector_type(2)));
__device__ __forceinline__ unsigned pk2(float lo, float hi) { f32x2_pk v = {lo, hi}; bf16x2_pk b = __builtin_convertvector(v, bf16x2_pk); return __builtin_bit_cast(unsigned, b); }
namespace pg8 {
#define PG8_LAS __attribute__((address_space(3)))
typedef unsigned short bf16_t;
typedef short bf16x8 __attribute__((ext_vector_type(8)));
typedef float f32x4 __attribute__((ext_vector_type(4)));
typedef unsigned u32x4 __attribute__((ext_vector_type(4)));
constexpr int BM = 256, BK = 64, HALF = 128, HTB = HALF * BK * 2  , STAGE_BYTES = 8 * HTB, NXCD = 8, WGM = 8;

__host__ __device__ __forceinline__ int lds_byte(int r, int c) { const int st = (r >> 4) * 2 + (c >> 5), rr = r & 15, cc = c & 31, ob = rr * 64 + cc * 2; return st * 1024 + (ob ^ (((ob >> 9) & 1) << 5)); }
__host__ __device__ __forceinline__ void stage_rc(int b, int& R, int& C) { const int st = b / 1024, sb = b % 1024, swz = sb ^ (((sb >> 9) & 1) << 5); R = (st >> 1) * 16 + swz / 64; C = (st & 1) * 32 + (swz % 64) / 2; }
__host__ __device__ __forceinline__ int perm32(int rho) { const int n = rho >> 4, i = rho & 15; return 8 * (i >> 2) + 4 * n + (i & 3); }

struct Unit { int pm, pn; };
struct Gemm { const bf16_t* A; const bf16_t* Bt; int M, N, K; };

struct StaticOrder {
    int nM, nN, nwg, G, c;
    __host__ __device__ void init(int M, int N, int G_, int c_) { nM = M / BM; nN = N / BM; nwg = nM * nN; G = G_; c = c_; }
    __host__ __device__ bool next(int i, Unit& u) const {
        const long L = (long)i * G + c; if (L >= nwg) return false;
        int wgid = (int)L; { const int q = nwg / NXCD, r = nwg % NXCD, xcd = wgid % NXCD, off = wgid / NXCD; wgid = (xcd < r ? xcd * (q + 1) : r * (q + 1) + (xcd - r) * q) + off; }
        const int nig = WGM * nN, gid = wgid / nig, fm = gid * WGM, gsz = (nM - fm) < WGM ? (nM - fm) : WGM;
        u.pm = fm + ((wgid % nig) % gsz); u.pn = (wgid % nig) / gsz; return true;
    }
    __device__ __forceinline__ void a_ready(const Unit&) const {}
    __device__ __forceinline__ void done(const Unit&) const {}
};

typedef float f32x2_cv __attribute__((ext_vector_type(2))); typedef __bf16 bf16x2_cv __attribute__((ext_vector_type(2)));
__device__ __forceinline__ unsigned cvt_pk_bf16(float lo, float hi) { f32x2_cv v = {lo, hi}; bf16x2_cv b = __builtin_convertvector(v, bf16x2_cv); return __builtin_bit_cast(unsigned, b); }
template <class Epi, class Sched, bool ALIGN_EPI = false, bool SP2 = false>
__device__ __forceinline__ void gemm_phase(PG8_LAS unsigned char* lds, const Gemm g, const Sched& S, const Epi& E) {
    int tid_ = threadIdx.x; asm volatile("" : "+v"(tid_));
    const int tid = tid_, wid = __builtin_amdgcn_readfirstlane(tid >> 6), lane = tid & 63, wr = wid >> 2, wc = wid & 3, fr = lane & 15, fq = lane >> 4;
    const int K = g.K, nt = K / BK;
    unsigned voffA[2], voffB[2];
#pragma unroll
    for (int i = 0; i < 2; ++i) { int R, C; stage_rc(tid * 16 + i * 8192, R, C); const int Rb = Epi::PERM ? ((R & ~31) + perm32(R & 31)) : R;
        voffA[i] = (unsigned)(R * K + C) * 2u; voffB[i] = (unsigned)(Rb * K + C) * 2u; }
    const size_t kstep = (size_t)(BK * 2);
    const size_t hstep = (size_t)HALF * K * 2;
    const size_t tstep = 2 * hstep;
    const unsigned ldsw = (unsigned)wid * 1024u;
    const int aoff = lds_byte(wr * 64 + fr, fq * 8), boff = lds_byte(wc * 32 + fr, fq * 8);
#define PG8_SA(b, h) (((b) * 2 + (h)) * HTB)
#define PG8_SB(b, h) ((4 + (b) * 2 + (h)) * HTB)
#define PG8_STAGE(bufoff, gbase, voff) do { _Pragma("unroll") for (int _i = 0; _i < 2; ++_i) \
        __builtin_amdgcn_global_load_lds((const unsigned*)((const char*)(gbase) + (voff)[_i]), (PG8_LAS unsigned*)(lds + (bufoff) + ldsw + _i * 8192), 16, 0, 0); } while (0)
#define PG8_LDA(dst, b, h) do { _Pragma("unroll") for (int m = 0; m < 4; ++m) _Pragma("unroll") for (int k = 0; k < 2; ++k) dst[m][k] = *(const PG8_LAS bf16x8*)(lds + PG8_SA(b, h) + aoff + m * 2048 + k * 1024); } while (0)
#define PG8_LDB(dst, b, h) do { _Pragma("unroll") for (int n = 0; n < 2; ++n) _Pragma("unroll") for (int k = 0; k < 2; ++k) dst[n][k] = *(const PG8_LAS bf16x8*)(lds + PG8_SB(b, h) + boff + n * 2048 + k * 1024); } while (0)
#define PG8_MMA(ai, bj, At, Bt) do { __builtin_amdgcn_s_setprio(1); _Pragma("unroll") for (int m = 0; m < 4; ++m) _Pragma("unroll") for (int n = 0; n < 2; ++n) _Pragma("unroll") for (int k = 0; k < 2; ++k) \
        acc[ai][bj][m][n] = __builtin_amdgcn_mfma_f32_16x16x32_bf16(Bt[n][k], At[m][k], acc[ai][bj][m][n], 0, 0, 0); __builtin_amdgcn_s_setprio(0); } while (0)
#define PG8_WAIT_V(n) asm volatile("s_waitcnt vmcnt(" #n ")" ::: "memory")
#define PG8_WAIT_L(n) asm volatile("s_waitcnt lgkmcnt(" #n ")" ::: "memory")
#define PG8_BAR __builtin_amdgcn_s_barrier()
#define PG8_SCHED __builtin_amdgcn_sched_barrier(0)
    Unit cur, nxt; int ui = 0;
    if (!S.next(0, cur)) return;
    f32x4 acc[2][2][4][2];
#pragma unroll
    for (int a = 0; a < 2; ++a)
#pragma unroll
        for (int b = 0; b < 2; ++b)
#pragma unroll
            for (int m = 0; m < 4; ++m)
#pragma unroll
                for (int n = 0; n < 2; ++n) acc[a][b][m][n] = (f32x4){0.f, 0.f, 0.f, 0.f};
    bf16x8 At[4][2], B0[2][2], B1[2][2];
    const char* cA = (const char*)g.A + (size_t)cur.pm * tstep; const char* cB = (const char*)g.Bt + (size_t)cur.pn * tstep;
    S.a_ready(cur);
    if constexpr (SP2) {
        PG8_STAGE(PG8_SB(0, 0), cB, voffB); PG8_STAGE(PG8_SB(0, 1), cB + hstep, voffB); PG8_STAGE(PG8_SA(0, 0), cA, voffA); PG8_STAGE(PG8_SA(0, 1), cA + hstep, voffA);
        if (wr == 1) PG8_BAR;
        PG8_WAIT_V(2); PG8_BAR;
        PG8_STAGE(PG8_SB(1, 0), cB + kstep, voffB); PG8_STAGE(PG8_SA(1, 0), cA + kstep, voffA); PG8_STAGE(PG8_SB(1, 1), cB + hstep + kstep, voffB);
        PG8_WAIT_V(6); PG8_BAR;
    } else {
        PG8_STAGE(PG8_SB(0, 0), cB, voffB); PG8_STAGE(PG8_SA(0, 0), cA, voffA); PG8_STAGE(PG8_SB(0, 1), cB + hstep, voffB); PG8_STAGE(PG8_SA(0, 1), cA + hstep, voffA);
        if (wr == 1) PG8_BAR;
        PG8_WAIT_V(4); PG8_BAR;
        PG8_STAGE(PG8_SB(1, 0), cB + kstep, voffB); PG8_STAGE(PG8_SA(1, 0), cA + kstep, voffA); PG8_STAGE(PG8_SB(1, 1), cB + hstep + kstep, voffB);
        PG8_WAIT_V(6); PG8_BAR;
    }
    for (;;) {
        const bool has_next = S.next(ui + 1, nxt);
        const char* nA = has_next ? (const char*)g.A + (size_t)nxt.pm * tstep : cA; const char* nB = has_next ? (const char*)g.Bt + (size_t)nxt.pn * tstep : cB;
        for (int t = 0; t < nt; t += 2) {
            const bool last = (t == nt - 2);
            const char* a1 = cA + (size_t)(t + 1) * kstep;
            const char* a2 = last ? nA : cA + (size_t)(t + 2) * kstep; const char* b2 = last ? nB : cB + (size_t)(t + 2) * kstep;
            const char* a3 = a2 + kstep; const char* b3 = b2 + kstep;
            if (last && has_next) S.a_ready(nxt);
            if constexpr (SP2) {
            PG8_LDB(B0, 0, 0); PG8_LDB(B1, 0, 1); PG8_SCHED; PG8_LDA(At, 0, 0); PG8_STAGE(PG8_SA(1, 1), a1 + hstep, voffA);
            PG8_WAIT_V(8); PG8_WAIT_L(0); PG8_BAR; PG8_MMA(0, 0, At, B0); PG8_MMA(0, 1, At, B1); PG8_BAR; PG8_SCHED;
            PG8_LDA(At, 0, 1); PG8_STAGE(PG8_SB(0, 0), b2, voffB); PG8_STAGE(PG8_SB(0, 1), b2 + hstep, voffB); PG8_STAGE(PG8_SA(0, 0), a2, voffA);
            PG8_WAIT_V(8); PG8_WAIT_L(0); PG8_BAR; PG8_MMA(1, 0, At, B0); PG8_MMA(1, 1, At, B1); PG8_BAR; PG8_SCHED;
            PG8_LDB(B0, 1, 0); PG8_LDB(B1, 1, 1); PG8_SCHED; PG8_LDA(At, 1, 0); PG8_STAGE(PG8_SA(0, 1), a2 + hstep, voffA);
            PG8_WAIT_V(8); PG8_WAIT_L(0); PG8_BAR; PG8_MMA(0, 0, At, B0); PG8_MMA(0, 1, At, B1); PG8_BAR; PG8_SCHED;
            PG8_LDA(At, 1, 1); PG8_STAGE(PG8_SB(1, 0), b3, voffB); PG8_STAGE(PG8_SB(1, 1), b3 + hstep, voffB); PG8_STAGE(PG8_SA(1, 0), a3, voffA);
            PG8_WAIT_V(8); PG8_WAIT_L(0); PG8_BAR; PG8_MMA(1, 0, At, B0); PG8_MMA(1, 1, At, B1); PG8_BAR; PG8_SCHED;
            } else {
            PG8_LDB(B0, 0, 0); PG8_SCHED; PG8_LDA(At, 0, 0); PG8_STAGE(PG8_SA(1, 1), a1 + hstep, voffA);
            PG8_WAIT_L(8); PG8_BAR; PG8_WAIT_L(0); PG8_MMA(0, 0, At, B0); PG8_BAR; PG8_SCHED;
            PG8_LDB(B1, 0, 1); PG8_STAGE(PG8_SB(0, 0), b2, voffB);
            PG8_BAR; PG8_WAIT_L(0); PG8_MMA(0, 1, At, B1); PG8_BAR;
            PG8_LDA(At, 0, 1); PG8_STAGE(PG8_SA(0, 0), a2, voffA);
            PG8_BAR; PG8_WAIT_L(0); PG8_MMA(1, 0, At, B0); PG8_BAR; PG8_SCHED;
            PG8_STAGE(PG8_SB(0, 1), b2 + hstep, voffB);
            PG8_WAIT_V(6); PG8_BAR; PG8_MMA(1, 1, At, B1); PG8_BAR;
            PG8_LDB(B0, 1, 0); PG8_SCHED; PG8_LDA(At, 1, 0); PG8_STAGE(PG8_SA(0, 1), a2 + hstep, voffA);
            PG8_WAIT_L(8); PG8_BAR; PG8_WAIT_L(0); PG8_MMA(0, 0, At, B0); PG8_BAR; PG8_SCHED;
            PG8_LDB(B1, 1, 1); PG8_STAGE(PG8_SB(1, 0), b3, voffB);
            PG8_BAR; PG8_WAIT_L(0); PG8_MMA(0, 1, At, B1); PG8_BAR;
            PG8_LDA(At, 1, 1); PG8_STAGE(PG8_SA(1, 0), a3, voffA);
            PG8_BAR; PG8_WAIT_L(0); PG8_MMA(1, 0, At, B0); PG8_BAR; PG8_SCHED;
            PG8_STAGE(PG8_SB(1, 1), b3 + hstep, voffB);
            PG8_WAIT_V(6); PG8_BAR; PG8_MMA(1, 1, At, B1); PG8_BAR;
            }
        }
        if constexpr (ALIGN_EPI) { if (wr == 0) PG8_BAR; }
        if constexpr (!Epi::AFTER_DRAIN) { E(acc, cur, wr, wc, fr, fq); S.done(cur); }
        if (!has_next) break;
#pragma unroll
        for (int a = 0; a < 2; ++a)
#pragma unroll
            for (int b = 0; b < 2; ++b)
#pragma unroll
                for (int m = 0; m < 4; ++m)
#pragma unroll
                    for (int n = 0; n < 2; ++n) acc[a][b][m][n] = (f32x4){0.f, 0.f, 0.f, 0.f};
        cur = nxt; cA = nA; cB = nB; ++ui;
        if constexpr (ALIGN_EPI) { if (wr == 1) PG8_BAR; }
    }
    PG8_WAIT_V(0);
    if constexpr (!ALIGN_EPI) { if (wr == 0) PG8_BAR; }
    PG8_BAR;
    if constexpr (Epi::AFTER_DRAIN) { E.fused(acc, cur, wr, wc, fr, fq, lds, wid, lane); S.done(cur); }
#undef PG8_SA
#undef PG8_SB
#undef PG8_STAGE
#undef PG8_LDA
#undef PG8_LDB
#undef PG8_MMA
#undef PG8_WAIT_V
#undef PG8_WAIT_L
#undef PG8_BAR
#undef PG8_SCHED
}
}
namespace pg8 {
typedef unsigned u32x2 __attribute__((ext_vector_type(2)));
__device__ __forceinline__ float sigmoidf_(float x) { return 1.0f / (1.0f + __expf(-x)); }
struct EpiBf {
    static constexpr bool PERM = true, AFTER_DRAIN = false;
    bf16_t* O; int ldc; int act;
    __device__ __forceinline__ void operator()(const f32x4 (&acc)[2][2][4][2], const Unit& u, int wr, int wc, int fr, int fq) const {
        const int row0 = u.pm * BM + wr * 64 + fr, col0 = u.pn * BM + wc * 32 + 8 * fq;
#pragma unroll
        for (int ai = 0; ai < 2; ++ai)
#pragma unroll
            for (int m = 0; m < 4; ++m) { bf16_t* rowp = O + (size_t)(row0 + ai * HALF + m * 16) * ldc + col0;
#pragma unroll
                for (int bj = 0; bj < 2; ++bj) { f32x4 v0 = acc[ai][bj][m][0], v1 = acc[ai][bj][m][1];
                    if (act == 1) {
#pragma unroll
                        for (int j = 0; j < 4; ++j) { v0[j] = sigmoidf_(v0[j]); v1[j] = sigmoidf_(v1[j]); } }
                    u32x4 w; w.x = cvt_pk_bf16(v0[0], v0[1]); w.y = cvt_pk_bf16(v0[2], v0[3]); w.z = cvt_pk_bf16(v1[0], v1[1]); w.w = cvt_pk_bf16(v1[2], v1[3]);
                    *(u32x4*)(rowp + bj * HALF) = w; } }
    }
};
struct EpiSwiglu {
    static constexpr bool PERM = true, AFTER_DRAIN = false;
    bf16_t* O; int ldc;
    __device__ __forceinline__ void operator()(const f32x4 (&acc)[2][2][4][2], const Unit& u, int wr, int wc, int fr, int fq) const {
        const int row0 = u.pm * BM + wr * 64 + fr, col0 = u.pn * HALF + wc * 32 + 8 * fq;
#pragma unroll
        for (int ai = 0; ai < 2; ++ai)
#pragma unroll
            for (int m = 0; m < 4; ++m) { bf16_t* rowp = O + (size_t)(row0 + ai * HALF + m * 16) * ldc + col0;
                f32x4 v0, v1;
#pragma unroll
                for (int j = 0; j < 4; ++j) { const float a0 = acc[ai][0][m][0][j], a1 = acc[ai][0][m][1][j];
                    v0[j] = a0 * sigmoidf_(a0) * acc[ai][1][m][0][j]; v1[j] = a1 * sigmoidf_(a1) * acc[ai][1][m][1][j]; }
                u32x4 w; w.x = cvt_pk_bf16(v0[0], v0[1]); w.y = cvt_pk_bf16(v0[2], v0[3]); w.z = cvt_pk_bf16(v1[0], v1[1]); w.w = cvt_pk_bf16(v1[2], v1[3]);
                *(u32x4*)rowp = w; }
    }
};
struct EpiF32 {
    static constexpr bool PERM = false, AFTER_DRAIN = false;
    float* C; int ldc;
    __device__ __forceinline__ void operator()(const f32x4 (&acc)[2][2][4][2], const Unit& u, int wr, int wc, int fr, int fq) const {
        const int row0 = u.pm * BM + wr * 64 + fr, col0 = u.pn * BM + wc * 32 + 4 * fq;
#pragma unroll
        for (int ai = 0; ai < 2; ++ai)
#pragma unroll
            for (int m = 0; m < 4; ++m) { float* rowp = C + (size_t)(row0 + ai * HALF + m * 16) * ldc + col0;
#pragma unroll
                for (int bj = 0; bj < 2; ++bj)
#pragma unroll
                    for (int n = 0; n < 2; ++n) *(f32x4*)(rowp + bj * HALF + n * 16) = acc[ai][bj][m][n]; }
    }
};
struct EpiUp {
    static constexpr bool PERM = false, AFTER_DRAIN = false;
    const bf16_t* gates; int ldg; int gcol0; float* T; bf16_t* GU; int mode;
    __device__ __forceinline__ void operator()(const f32x4 (&acc)[2][2][4][2], const Unit& u, int wr, int wc, int fr, int fq) const {
        const int row0 = u.pm * BM + wr * 64 + fr, col0 = u.pn * BM + wc * 32 + 4 * fq;
#pragma unroll
        for (int ai = 0; ai < 2; ++ai)
#pragma unroll
            for (int m = 0; m < 4; ++m) { const size_t row = (size_t)(row0 + ai * HALF + m * 16);
#pragma unroll
                for (int bj = 0; bj < 2; ++bj)
#pragma unroll
                    for (int n = 0; n < 2; ++n) { const int col = col0 + bj * HALF + n * 16;
                        const u32x2 g = *(const u32x2*)(gates + row * ldg + gcol0 + col);
                        f32x4 gv; gv[0] = __uint_as_float(g.x << 16); gv[1] = __uint_as_float(g.x & 0xffff0000u); gv[2] = __uint_as_float(g.y << 16); gv[3] = __uint_as_float(g.y & 0xffff0000u);
                        f32x4 v = acc[ai][bj][m][n] * gv; float* tp = T + row * 1024 + col;
                        if (mode == 0) { *(f32x4*)tp = v; }
                        else if (mode == 1) { *(f32x4*)tp = *(const f32x4*)tp + v; }
                        else { v = v + *(const f32x4*)tp; u32x2 w; w.x = cvt_pk_bf16(v[0], v[1]); w.y = cvt_pk_bf16(v[2], v[3]); *(u32x2*)(GU + row * 1024 + col) = w; } } }
    }
};
}
#define XB_TMO      128
#define XB_XCNT(j)  (256  + 64 * (j))
#define XB_XSUB(j)  (1280 + 64 * (j))
#define XB_XGEN(j)  (2304 + 64 * (j))
#define XB_TOP      3328
#define XB_TOPGEN   3392
#define XCD_BAR_WORDS 3456
#define XB_SPIN_CAP (1u << 18)

__device__ __forceinline__ unsigned xb_ld(unsigned* p)              { return __hip_atomic_load(p, __ATOMIC_RELAXED, __HIP_MEMORY_SCOPE_AGENT); }
__device__ __forceinline__ unsigned xb_add(unsigned* p, unsigned v) { return __hip_atomic_fetch_add(p, v, __ATOMIC_RELAXED, __HIP_MEMORY_SCOPE_AGENT); }
__device__ __forceinline__ unsigned xb_xcc_id() { return (unsigned)__builtin_amdgcn_s_getreg((3 << 11) | 20) & 0xFu; }
#define XB_SPIN(cond, bar) do { unsigned _sp = 0; while (cond) { __builtin_amdgcn_s_sleep(1); \
    if ((++_sp & 255u) == 0u) { if (xb_ld(&(bar)[XB_TMO])) break; if (_sp > XB_SPIN_CAP) { atomicAdd(&(bar)[XB_TMO], 1u); break; } } } } while (0)

struct XcdBarrier {
    unsigned* bar; unsigned x;
    volatile LAS unsigned* st;
};

__device__ __forceinline__ XcdBarrier xcd_barrier_post(unsigned* bar, volatile LAS unsigned* st) {
    XcdBarrier b; b.bar = bar; b.x = xb_xcc_id(); b.st = st;
    if (threadIdx.x == 0) (void)xb_add(&bar[XB_XCNT(b.x)], 1u);
    return b;
}
__device__ __forceinline__ void xcd_barrier_complete(unsigned* bar, unsigned x, unsigned& nloc, unsigned& nx) {
    const unsigned G = gridDim.x * gridDim.y * gridDim.z;
    unsigned sum, cnt, mine, sp = 0u;
    for (;;) {
        sum = 0u; cnt = 0u; mine = 0u;
#pragma unroll
        for (unsigned j = 0; j < 16; ++j) { const unsigned c = xb_ld(&bar[XB_XCNT(j)]); sum += c; cnt += (c > 0u) ? 1u : 0u; mine = (j == x) ? c : mine; }
        if (sum == G) break;
        __builtin_amdgcn_s_sleep(1);
        if ((++sp & 255u) == 0u) { if (xb_ld(&bar[XB_TMO])) break; if (sp > XB_SPIN_CAP) { atomicAdd(&bar[XB_TMO], 1u); break; } }
    }
    nloc = mine > 0u ? mine : 1u; nx = cnt > 0u ? cnt : 1u;
}

__device__ __forceinline__ void xcd_barrier(const XcdBarrier& b) {
    asm volatile("s_waitcnt vmcnt(0)" ::: "memory");
    __syncthreads();
    if (threadIdx.x == 0) {
        unsigned* bar = b.bar;
        __builtin_amdgcn_s_waitcnt(0);
        unsigned nloc = b.st[0], nx = b.st[1];
        if (nloc == 0u) { xcd_barrier_complete(bar, b.x, nloc, nx); b.st[0] = nloc; b.st[1] = nx; }
        const unsigned old = xb_add(&bar[XB_XSUB(b.x)], 1u);
        const unsigned gen = old / nloc;
        if (old + 1u == (gen + 1u) * nloc) {
            __builtin_amdgcn_fence(__ATOMIC_RELEASE, "agent");
            asm volatile("s_waitcnt vmcnt(0)" ::: "memory");
            const unsigned og = xb_add(&bar[XB_TOP], 1u);
            const unsigned tg = og / nx;
            if (og + 1u == (tg + 1u) * nx) xb_add(&bar[XB_TOPGEN], 1u);
            else XB_SPIN(xb_ld(&bar[XB_TOPGEN]) == tg, bar);
            __builtin_amdgcn_fence(__ATOMIC_ACQUIRE, "agent");
            xb_add(&bar[XB_XGEN(b.x)], 1u);
            asm volatile("s_waitcnt vmcnt(0)" ::: "memory");
        } else {
            XB_SPIN(xb_ld(&bar[XB_XGEN(b.x)]) == gen, bar);
            __builtin_amdgcn_fence(__ATOMIC_ACQUIRE, "agent");
            asm volatile("s_waitcnt vmcnt(0)" ::: "memory");
        }
    }
    __syncthreads();
}
constexpr int NWAVES = 8;
constexpr int M = 12288, MP = 8192, DM = 1024, FF = 2816, NL = 2, NGRP = 5, NMOD = 9 * 1024;
constexpr int NKEYS = 8192 + 4 * 1280;
constexpr float ALPHA = 1.41421356237f, LN_EPS = 1e-5f, RMS_EPS = 1e-6f, GN_EPS = 64e-5f;
constexpr float QSCALE = 0.125f * 1.4426950408889634f;
constexpr size_t MiB = 1u << 20;
constexpr size_t WS_CTL = 0, CTL_ZERO_BYTES = 1 * MiB;
constexpr size_t WS_MOD = 1 * MiB;
constexpr size_t WS_LAM = WS_MOD + 512 * 1024;
constexpr size_t WS_LORA = 2 * MiB;
constexpr size_t WS_BON = 3 * MiB;
constexpr size_t WS_WB = 4 * MiB;
constexpr size_t WS_H = 109 * MiB;
constexpr size_t WS_BIG = 133 * MiB;
constexpr size_t WS_END = 352 * MiB;
constexpr size_t WL_W1A = 0, WL_W1B = 5767168, WL_WIN = 8650752, WL_WUP = 16252928, WL_WO = 17825792, WL_W2A = 18874368, WL_W2B = 24641536, WL_SIZE = 27525120;
constexpr int WIN_ATT = 0, WIN_RWKV = 2304, WIN_GATE = 4352, WIN_ROWS = 7424;
constexpr size_t B_ACT = 0, B_Z2 = 66 * MiB;
constexpr size_t B_PQA = 0, B_PQR = 0;
constexpr size_t B_QA = 54 * MiB, B_QB = 66 * MiB, B_KA = 78 * MiB, B_VA = B_KA + 3328 * 1024, B_KB = B_VA + 3328 * 1024, B_VB = B_KB + 13 * MiB;
constexpr size_t B_SR = 111 * MiB, B_SK = 123 * MiB, B_SKK = 135 * MiB, B_SV = 147 * MiB, B_SA0 = 159 * MiB, B_SA1 = 171 * MiB, B_SW0 = 183 * MiB, B_SW1 = 195 * MiB, B_G = 207 * MiB;
constexpr size_t B_OA = 0, B_OB = 12 * MiB, B_OF = 24 * MiB, B_OBW = 36 * MiB, B_OC = 54 * MiB;
constexpr size_t B_GATES = 66 * MiB, B_T = 138 * MiB, B_GU = 186 * MiB, B_Z1 = 0;
static_assert(B_VB + 13 * MiB <= B_SR && B_G + 12 * MiB <= WS_END - WS_BIG && B_GU + 24 * MiB <= WS_END - WS_BIG, "BIG map");
constexpr size_t O_Y = 0, O_NAK = 12582912, O_NAV = 14680064, O_NDK = 16777216, O_NDV = 25165824, O_NST = 33554432, O_TOTAL = 37748736;
constexpr int RING_OFF = 0, RING_BYTES = 131072, LDSCTL_OFF = RING_BYTES, MISC_OFF = LDSCTL_OFF + 320, LDS_BYTES = 147456;
constexpr int CW_TMO = 0, CW_CODE = 1, CW_BAR = 4096;
struct Args { const float* in[32]; float* out; unsigned char* ws; int ph_lo, ph_hi; };
struct Frame {
    LAS unsigned char* lds;
    int tid, lane, wave, G, bid, gw, NGW;
    const Args* a; float* out; unsigned char* ws; unsigned char* big;
};
__device__ __forceinline__ float bflo(unsigned w) { return __uint_as_float(w << 16); }
__device__ __forceinline__ float bfhi(unsigned w) { return __uint_as_float(w & 0xffff0000u); }
__device__ __forceinline__ float bf1(bf16 v) { return __uint_as_float((unsigned)v << 16); }
__device__ __forceinline__ float sigm(float x) { return 1.0f / (1.0f + __expf(-x)); }
__device__ __forceinline__ float wave_sum(float v) {
#pragma unroll
    for (int o = 1; o < 64; o <<= 1) v += __shfl_xor(v, o);
    return v;
}
__device__ __forceinline__ float wave_max(float v) {
#pragma unroll
    for (int o = 1; o < 64; o <<= 1) v = fmaxf(v, __shfl_xor(v, o));
    return v;
}
__device__ __forceinline__ float red16(float v) { v += __shfl_xor(v, 1); v += __shfl_xor(v, 2); v += __shfl_xor(v, 4); v += __shfl_xor(v, 8); return v; }
__device__ __forceinline__ int row_group(int m) { return m < MP ? 0 : 1 + ((m - MP) >> 10); }
__device__ __forceinline__ int key_base(int seq) { return seq < 32 ? seq * 256 : 8192 + (seq - 32) * 1280; }
__device__ __forceinline__ const float* modp(const Frame& F, int l, int g, int i) { return (const float*)(F.ws + WS_MOD) + ((size_t)(l * NGRP + g) * 9 + i) * 1024; }
__device__ __forceinline__ bf16* wlayer(const Frame& F, int l) { return (bf16*)(F.ws + WS_WB) + (size_t)l * WL_SIZE; }

__device__ __forceinline__ void p0_item(const float* Wsrc  , int ldw, int K, bf16* WTrow0  , int kb, bool zero, LAS float* scr, int lane) {
    const int k0 = 64 * kb;
    if (zero) {
#pragma unroll
        for (int j = 0; j < 4; ++j) { const int n = (lane >> 3) + 8 * j; *(GAS v4u*)(WTrow0 + (size_t)n * K + k0 + 8 * (lane & 7)) = (v4u){0u, 0u, 0u, 0u}; }
        return;
    }
#pragma unroll 8
    for (int i = 0; i < 32; ++i) { const int kk = 2 * i + (lane >> 5); scr[kk * 33 + (lane & 31)] = Wsrc[(size_t)(k0 + kk) * ldw + (lane & 31)]; }
    LDS_WAIT(); asm volatile("" ::: "memory");
    const int c = lane & 7;
#pragma unroll
    for (int j = 0; j < 4; ++j) { const int n = (lane >> 3) + 8 * j; const LAS float* s = scr + (8 * c) * 33 + n;
        v4u o; o.x = pk2(s[0 * 33], s[1 * 33]); o.y = pk2(s[2 * 33], s[3 * 33]); o.z = pk2(s[4 * 33], s[5 * 33]); o.w = pk2(s[6 * 33], s[7 * 33]);
        *(GAS v4u*)(WTrow0 + (size_t)n * K + k0 + 8 * c) = o; }
    LDS_WAIT(); asm volatile("" ::: "memory");
}
constexpr int IT_W1A = 16 * 176, IT_W1B = 44 * 32, IT_WIN = 16 * 232, IT_WUP = 3 * 8 * 32, IT_WO = 16 * 32, IT_LAYER = 2 * IT_W1A + 2 * IT_W1B + IT_WIN + IT_WUP + IT_WO;
__device__ __forceinline__ void conv_item(const Frame& F, int it, LAS float* scr) {
    const int l = it / IT_LAYER; int r = it % IT_LAYER; bf16* wl = wlayer(F, l); const int lane = F.lane;
    for (int f = 0; f < 2; ++f) {
        if (r < IT_W1A) { const int kb = r / 176, db = r % 176, tile = db >> 3, half = (db >> 2) & 1, q = db & 3;
            p0_item(F.a->in[13] + (size_t)(l * 2 + f) * 1024 * 5632 + half * 2816 + tile * 128 + q * 32, 5632, 1024, wl + (f ? WL_W2A : WL_W1A) + (size_t)(32 * db) * 1024, kb, false, scr, lane); return; }
        r -= IT_W1A;
        if (r < IT_W1B) { const int kb = r / 32, db = r % 32;
            p0_item(F.a->in[14] + (size_t)(l * 2 + f) * 2816 * 1024 + 32 * db, 1024, 2816, wl + (f ? WL_W2B : WL_W1B) + (size_t)(32 * db) * 2816, kb, false, scr, lane); return; }
        r -= IT_W1B;
    }
    if (r < IT_WIN) { const int kb = r / 232, db = r % 232, row = 32 * db; int src = 0; bool zero = false;
        if (row < WIN_RWKV) src = 3072 + row; else if (row < WIN_GATE) { const int rr = row - WIN_RWKV; if (rr < 1920) src = 5376 + rr; else zero = true; } else src = row - WIN_GATE;
        p0_item(F.a->in[15] + (size_t)l * 1024 * 7296 + src, 7296, 1024, wl + WL_WIN + (size_t)row * 1024, kb, zero, scr, lane); return; }
    r -= IT_WIN;
    if (r < IT_WUP) { const int i = r / 256, r2 = r % 256, kb = r2 / 32, db = r2 % 32;
        p0_item(F.a->in[30] + (size_t)(l * 3 + i) * 512 * 1024 + 32 * db, 1024, 512, wl + WL_WUP + (size_t)i * 524288 + (size_t)(32 * db) * 512, kb, false, scr, lane); return; }
    r -= IT_WUP;
    { const int kb = r / 32, db = r % 32;
      p0_item(F.a->in[31] + (size_t)l * 1024 * 1024 + 32 * db, 1024, 1024, wl + WL_WO + (size_t)(32 * db) * 1024, kb, false, scr, lane); }
}
__device__ __forceinline__ void phase_conv(const Frame& F) {
    LAS float* red = (LAS float*)(F.lds + RING_OFF);
    for (int task = F.bid; task < NL * (NMOD / 64); task += F.G) {
        const int l = task / (NMOD / 64), n = (task % (NMOD / 64)) * 64 + F.lane;
        const float* wm = F.a->in[9] + (size_t)l * 1024 * NMOD + n;
        float acc[NGRP] = {0.f, 0.f, 0.f, 0.f, 0.f};
        const int k0 = F.wave * 128;
#pragma unroll 4
        for (int k = k0; k < k0 + 128; ++k) {
            const float w = wm[(size_t)k * NMOD];
#pragma unroll
            for (int g = 0; g < NGRP; ++g) { const float cv = g == 0 ? F.a->in[8][k] : F.a->in[7][(g - 1) * 1024 + k]; acc[g] += cv * sigm(cv) * w; }
        }
#pragma unroll
        for (int g = 0; g < NGRP; ++g) red[(F.wave * NGRP + g) * 64 + F.lane] = acc[g];
        __syncthreads();
        if (F.wave < NGRP) { float s = F.a->in[10][(size_t)l * NMOD + n];
#pragma unroll
            for (int w = 0; w < 8; ++w) s += red[(w * NGRP + F.wave) * 64 + F.lane];
            ((float*)(F.ws + WS_MOD))[(size_t)(l * NGRP + F.wave) * NMOD + n] = s; }
        __syncthreads();
    }
    LAS float* scr = (LAS float*)(F.lds + RING_OFF + F.wave * 16384);
    for (int it = F.gw; it < NL * IT_LAYER; it += F.NGW) conv_item(F, it, scr);
    bf16* lora = (bf16*)(F.ws + WS_LORA);
    const int gt = F.gw * 64 + F.lane, NT = F.NGW * 64;
    for (int e = gt; e < NL * 196608; e += NT) {
        const int l = e / 196608, r = e % 196608; float v;
        if (r < 65536) { const int d = r >> 15, c = (r >> 6) & 511, rr = r & 63; v = F.a->in[21][((size_t)(l * 2 + d) * 64 + rr) * 512 + c]; }
        else if (r < 131072) { const int r2 = r - 65536, d = r2 >> 15, c = (r2 >> 6) & 511, rr = r2 & 63; v = F.a->in[23][((size_t)(l * 2 + d) * 64 + rr) * 512 + c]; }
        else { const int r2 = r - 131072, c = r2 >> 7, rr = r2 & 127; v = F.a->in[24][((size_t)l * 128 + rr) * 512 + c]; }
        lora[e] = (bf16)f2bf(v);
    }
    if (F.bid == 0 && F.wave == 0) {
        for (int l = 0; l < NL; ++l) { const float* lv = F.a->in[17] + l * 256;
            const float d01 = wave_sum(lv[F.lane] * lv[64 + F.lane]), d23 = wave_sum(lv[128 + F.lane] * lv[192 + F.lane]);
            if (F.lane == 0) ((float*)(F.ws + WS_LAM))[l] = __expf(d01) - __expf(d23) + (0.8f - 0.6f * __expf(-0.3f * (float)l)); }
    }
}
__device__ __forceinline__ void phase_init(const Frame& F) {
    for (int m = F.gw; m < M; m += F.NGW) {
        const float* xr = m < MP ? F.a->in[0] + (size_t)m * DM : F.a->in[1] + (size_t)(m - MP) * DM;
        const int g = row_group(m); const float* sh = modp(F, 0, g, 0); const float* sc = modp(F, 0, g, 1);
        float* X = F.out + (size_t)m * DM; bf16* H = (bf16*)(F.ws + WS_H) + (size_t)m * DM;
#pragma unroll
        for (int j = 0; j < 4; ++j) { const int c = 4 * F.lane + 256 * j; const f32x4 v = *(const f32x4*)(xr + c), s1 = *(const f32x4*)(sc + c), s0 = *(const f32x4*)(sh + c);
            *(f32x4*)(X + c) = v; const f32x4 h = v * (s1 + 1.0f) + s0;
            unsigned long long o = (unsigned long long)pk2(h[0], h[1]) | ((unsigned long long)pk2(h[2], h[3]) << 32); *(unsigned long long*)(H + c) = o; }
    }
}
__device__ __forceinline__ void phase_ln(const Frame& F, int l, int s, const float* Z) {
    const float gs = (s == 1) ? 1.0f : 0.5f; const int l2 = s < 2 ? l : l + 1, s2 = s < 2 ? s + 1 : 0;
    const float* lng = F.a->in[11] + (size_t)(l * 3 + s) * DM; const float* lnb = F.a->in[12] + (size_t)(l * 3 + s) * DM;
    for (int m = F.gw; m < M; m += F.NGW) {
        const int g = row_group(m); const float* gate = modp(F, l, g, 3 * s + 2);
        float* X = F.out + (size_t)m * DM; const float* zr = Z + (size_t)m * DM; bf16* H = (bf16*)(F.ws + WS_H) + (size_t)m * DM;
        f32x4 v[4]; float sum = 0.f;
#pragma unroll
        for (int j = 0; j < 4; ++j) { const int c = 4 * F.lane + 256 * j; const f32x4 x = *(const f32x4*)(X + c), z = *(const f32x4*)(zr + c), gt = *(const f32x4*)(gate + c);
            v[j] = x * ALPHA + gt * z * gs; sum += (v[j][0] + v[j][1]) + (v[j][2] + v[j][3]); }
        const float mean = wave_sum(sum) * (1.0f / DM); float s2q = 0.f;
#pragma unroll
        for (int j = 0; j < 4; ++j) { v[j] = v[j] - mean; s2q += (v[j][0] * v[j][0] + v[j][1] * v[j][1]) + (v[j][2] * v[j][2] + v[j][3] * v[j][3]); }
        const float rstd = 1.0f / sqrtf(wave_sum(s2q) * (1.0f / DM) + LN_EPS);
#pragma unroll
        for (int j = 0; j < 4; ++j) { const int c = 4 * F.lane + 256 * j; const f32x4 xn = v[j] * rstd * *(const f32x4*)(lng + c) + *(const f32x4*)(lnb + c);
            *(f32x4*)(X + c) = xn;
            if (l2 < NL) { const f32x4 s1 = *(const f32x4*)(modp(F, l2, g, 3 * s2 + 1) + c), s0 = *(const f32x4*)(modp(F, l2, g, 3 * s2) + c); const f32x4 h = xn * (s1 + 1.0f) + s0;
                unsigned long long o = (unsigned long long)pk2(h[0], h[1]) | ((unsigned long long)pk2(h[2], h[3]) << 32); *(unsigned long long*)(H + c) = o; } }
    }
}
__device__ __forceinline__ float rope1(float x, int lane, int t) {
    const int i = lane & 15; const float pos = (float)((lane & 32) ? (t & 63) : (t >> 6));
    const float ang = pos * exp2f(-(float)i * 0.8304820237f);
    const float cs = cosf(ang), sn = sinf(ang); const float p = __shfl_xor(x, 16);
    return (lane & 16) ? (x * cs + p * sn) : (x * cs - p * sn);
}
__device__ __forceinline__ void phase_attprep(const Frame& F, int l) {
    const bf16* PQA = (const bf16*)(F.big + B_PQA);
    bf16* QA = (bf16*)(F.big + B_QA); bf16* QB = (bf16*)(F.big + B_QB); bf16* KA = (bf16*)(F.big + B_KA); bf16* VA = (bf16*)(F.big + B_VA); bf16* KB = (bf16*)(F.big + B_KB); bf16* VB = (bf16*)(F.big + B_VB);
    const int lane = F.lane; const float g0 = F.a->in[16][(l * 2 + 0) * 64 + lane], g1 = F.a->in[16][(l * 2 + 1) * 64 + lane];
    for (int m = F.gw; m < M; m += F.NGW) {
        const bool smp = m >= MP; const int seq = smp ? 32 + ((m - MP) >> 10) : (m >> 8), t = smp ? ((m - MP) & 1023) : (m & 255);
        const size_t key = (size_t)key_base(seq) + t; const bf16* pr = PQA + (size_t)m * 2304;
#pragma unroll
        for (int h = 0; h < 8; ++h) { const float x = bf1(pr[h * 64 + lane]); float xn = x * rsqrtf(wave_sum(x * x) * (1.0f / 64.0f) + RMS_EPS) * g0; if (smp) xn = rope1(xn, lane, t);
            QA[(size_t)m * 512 + h * 64 + lane] = (bf16)f2bf(xn * QSCALE); }
#pragma unroll
        for (int h = 0; h < 2; ++h) { const float x = bf1(pr[512 + h * 64 + lane]); float xn = x * rsqrtf(wave_sum(x * x) * (1.0f / 64.0f) + RMS_EPS) * g1; const float v = bf1(pr[640 + h * 64 + lane]);
            if (!smp) { const size_t o = ((size_t)((seq * 2 + l) * 2 + h) * 256 + t) * 64 + lane; F.out[O_NAK + o] = xn; F.out[O_NAV + o] = v; } else xn = rope1(xn, lane, t);
            KA[((size_t)h * NKEYS + key) * 64 + lane] = (bf16)f2bf(xn); VA[((size_t)h * NKEYS + key) * 64 + lane] = (bf16)f2bf(v); }
#pragma unroll
        for (int hc = 0; hc < 8; ++hc) { const int h = hc >> 1, c = hc & 1;
            float q = bf1(pr[768 + hc * 64 + lane]); float k = bf1(pr[1280 + hc * 64 + lane]); const float v = bf1(pr[1792 + hc * 64 + lane]);
            if (!smp) { const size_t o = ((size_t)((seq * 2 + l) * 4 + h) * 256 + t) * 128 + c * 64 + lane; F.out[O_NDK + o] = k; F.out[O_NDV + o] = v; } else { q = rope1(q, lane, t); k = rope1(k, lane, t); }
            QB[(size_t)m * 512 + hc * 64 + lane] = (bf16)f2bf(q * QSCALE);
            KB[((size_t)(h * 2 + c) * NKEYS + key) * 64 + lane] = (bf16)f2bf(k);
            VB[((size_t)h * NKEYS + key) * 128 + c * 64 + lane] = (bf16)f2bf(v); }
    }
    for (int it = F.gw; it < 4 * 256; it += F.NGW) { const int b = it >> 8, p = it & 255; const size_t key = (size_t)key_base(32 + b) + 1024 + p;
#pragma unroll
        for (int h = 0; h < 2; ++h) { const size_t s = ((size_t)((b * 2 + l) * 2 + h) * 256 + p) * 64 + lane;
            KA[((size_t)h * NKEYS + key) * 64 + lane] = (bf16)f2bf(F.a->in[2][s]); VA[((size_t)h * NKEYS + key) * 64 + lane] = (bf16)f2bf(F.a->in[3][s]); }
#pragma unroll
        for (int hc = 0; hc < 8; ++hc) { const int h = hc >> 1, c = hc & 1; const size_t s = ((size_t)((b * 2 + l) * 4 + h) * 256 + p) * 128 + c * 64 + lane;
            KB[((size_t)(h * 2 + c) * NKEYS + key) * 64 + lane] = (bf16)f2bf(F.a->in[4][s]); VB[((size_t)h * NKEYS + key) * 128 + c * 64 + lane] = (bf16)f2bf(F.a->in[5][s]); }
    }
}
struct RwkvBufs { bf16 *SR, *SK, *SKK, *SV, *SA0, *SA1, *G; _Float16 *SW0, *SW1; float* BON; };
__device__ __forceinline__ RwkvBufs rwkv_bufs(const Frame& F) {
    RwkvBufs b; b.SR = (bf16*)(F.big + B_SR); b.SK = (bf16*)(F.big + B_SK); b.SKK = (bf16*)(F.big + B_SKK); b.SV = (bf16*)(F.big + B_SV); b.SA0 = (bf16*)(F.big + B_SA0); b.SA1 = (bf16*)(F.big + B_SA1);
    b.G = (bf16*)(F.big + B_G); b.SW0 = (_Float16*)(F.big + B_SW0); b.SW1 = (_Float16*)(F.big + B_SW1); b.BON = (float*)(F.ws + WS_BON); return b;
}
__device__ __forceinline__ void mixed8(const bf16* PQR, const float* mu, int m, int cb, bool hp, bool hn, float (&o)[8]) {
    const v4u cur = *(const v4u*)(PQR + (size_t)m * 2048 + cb); v4u pv = {0u, 0u, 0u, 0u}, nv = {0u, 0u, 0u, 0u};
    if (hp) pv = *(const v4u*)(PQR + (size_t)(m - 1) * 2048 + cb);
    if (hn) nv = *(const v4u*)(PQR + (size_t)(m + 1) * 2048 + cb);
    const f32x4 m0 = *(const f32x4*)(mu + cb), m1 = *(const f32x4*)(mu + cb + 4);
#pragma unroll
    for (int w = 0; w < 4; ++w) { const float c0 = bflo(cur[w]), c1 = bfhi(cur[w]); const float mua = w < 2 ? m0[2 * w] : m1[2 * w - 4], mub = w < 2 ? m0[2 * w + 1] : m1[2 * w - 3];
        o[2 * w] = c0 + mua * (0.5f * (bflo(pv[w]) + bflo(nv[w])) - c0); o[2 * w + 1] = c1 + mub * (0.5f * (bfhi(pv[w]) + bfhi(nv[w])) - c1); }
}
__device__ __forceinline__ float mixed1(const bf16* PQR, float mu, int m, int c, bool hp, bool hn) {
    const float cur = bf1(PQR[(size_t)m * 2048 + c]); const float p = hp ? bf1(PQR[(size_t)(m - 1) * 2048 + c]) : 0.f, n = hn ? bf1(PQR[(size_t)(m + 1) * 2048 + c]) : 0.f;
    return cur + mu * (0.5f * (p + n) - cur);
}
__device__ __forceinline__ bf16x8 pack8(const float (&v)[8]) {
    v4u w; w.x = pk2(v[0], v[1]); w.y = pk2(v[2], v[3]); w.z = pk2(v[4], v[5]); w.w = pk2(v[6], v[7]); return __builtin_bit_cast(bf16x8, w);
}
__device__ __forceinline__ void phase_rwkvprep(const Frame& F, int l) {
    const bf16* PQR = (const bf16*)(F.big + B_PQR); const RwkvBufs B = rwkv_bufs(F);
    const float* mu = F.a->in[19] + (size_t)l * 1920; const bf16* lora = (const bf16*)(F.ws + WS_LORA) + (size_t)l * 196608;
    const bf16* W2T = lora; const bf16* A2T = lora + 65536; const bf16* G2T = lora + 131072;
    const float* w0 = F.a->in[20] + (size_t)l * 1024; const float* a0p = F.a->in[22] + (size_t)l * 1024;
    const float* kkp = F.a->in[25] + (size_t)l * 512; const float* kap = F.a->in[26] + (size_t)l * 512; const float* rkp = F.a->in[27] + (size_t)l * 512;
    const int lane = F.lane, col = lane & 15, q = lane >> 4;
    for (int task = F.gw; task < M / 16; task += F.NGW) {
        const int tok0 = task * 16;
        bf16x8 Aw[2][2], Aa[2][2];
        { const int m = tok0 + col; const bool smp = m >= MP; const int t = smp ? ((m - MP) & 1023) : (m & 255), T = smp ? 1024 : 256; const bool hp = t > 0, hn = t < T - 1; float v[8];
#pragma unroll
          for (int d = 0; d < 2; ++d)
#pragma unroll
              for (int s = 0; s < 2; ++s) {
                  mixed8(PQR, mu, m, 1536 + d * 64 + 32 * s + 8 * q, hp, hn, v);
#pragma unroll
                  for (int j = 0; j < 8; ++j) v[j] = 1.0f - 2.0f / (1.0f + __expf(2.0f * v[j]));
                  Aw[d][s] = pack8(v);
                  mixed8(PQR, mu, m, 1664 + d * 64 + 32 * s + 8 * q, hp, hn, v); Aa[d][s] = pack8(v); }
 }
        bool hp4[4], hn4[4];
#pragma unroll
        for (int j = 0; j < 4; ++j) { const int m = tok0 + 4 * q + j; const bool smp = m >= MP; const int t = smp ? ((m - MP) & 1023) : (m & 255), T = smp ? 1024 : 256; hp4[j] = t > 0; hn4[j] = t < T - 1; }
        for (int h = 0; h < 8; ++h) {
            float ss[4] = {0.f, 0.f, 0.f, 0.f}, bs[4] = {0.f, 0.f, 0.f, 0.f};
#pragma unroll 1
            for (int cbi = 0; cbi < 4; ++cbi) {
                const int c = 64 * h + 16 * cbi + col;
                f32x4 accw[2], acca[2];
#pragma unroll
                for (int d = 0; d < 2; ++d) { accw[d] = (f32x4){0.f, 0.f, 0.f, 0.f}; acca[d] = (f32x4){0.f, 0.f, 0.f, 0.f};
#pragma unroll
                    for (int s = 0; s < 2; ++s) {
                        const bf16x8 bw = *(const bf16x8*)(W2T + ((size_t)d * 512 + c) * 64 + 32 * s + 8 * q), ba = *(const bf16x8*)(A2T + ((size_t)d * 512 + c) * 64 + 32 * s + 8 * q);
                        accw[d] = __builtin_amdgcn_mfma_f32_16x16x32_bf16(Aw[d][s], bw, accw[d], 0, 0, 0);
                        acca[d] = __builtin_amdgcn_mfma_f32_16x16x32_bf16(Aa[d][s], ba, acca[d], 0, 0, 0); } }
                const float mur = mu[c], muk = mu[512 + c], muv = mu[1024 + c], w00 = w0[c], w01 = w0[512 + c], a00 = a0p[c], a01 = a0p[512 + c], kkc = kkp[c], kac = kap[c], rkc = rkp[c];
#pragma unroll
                for (int j = 0; j < 4; ++j) { const int m = tok0 + 4 * q + j; const size_t o = (size_t)m * 512 + c;
                    const float r = mixed1(PQR, mur, m, c, hp4[j], hn4[j]), k = mixed1(PQR, muk, m, 512 + c, hp4[j], hn4[j]), v = mixed1(PQR, muv, m, 1024 + c, hp4[j], hn4[j]);
                    const float dec0 = __expf(-0.6065306597f * sigm(w00 + accw[0][j])), dec1 = __expf(-0.6065306597f * sigm(w01 + accw[1][j]));
                    const float av0 = sigm(a00 + acca[0][j]), av1 = sigm(a01 + acca[1][j]);
                    const float kr = bf1((bf16)f2bf(k * kkc)); ss[j] += kr * kr; B.SKK[o] = (bf16)f2bf(kr);
                    const float kh0 = k * (1.0f + (av0 - 1.0f) * kac), kh1 = k * (1.0f + (av1 - 1.0f) * kac); bs[j] += r * (kh0 + kh1) * rkc;
                    B.SR[o] = (bf16)f2bf(r); B.SK[o] = (bf16)f2bf(k); B.SV[o] = (bf16)f2bf(v); B.SA0[o] = (bf16)f2bf(av0); B.SA1[o] = (bf16)f2bf(av1);
                    B.SW0[o] = (_Float16)dec0; B.SW1[o] = (_Float16)dec1; }
            }
#pragma unroll
            for (int j = 0; j < 4; ++j) { const float rn = rsqrtf(red16(ss[j]) + 1e-12f); const float bsum = red16(bs[j]); const int m = tok0 + 4 * q + j;
#pragma unroll
                for (int cbi = 0; cbi < 4; ++cbi) { bf16* pk = B.SKK + (size_t)m * 512 + 64 * h + 16 * cbi + col; *pk = (bf16)f2bf(bf1(*pk) * rn); }
                if (col == 0) B.BON[(size_t)m * 8 + h] = bsum; }
        }
        { bf16x8 Ag[4]; { const int m = tok0 + col; const bool smp = m >= MP; const int t = smp ? ((m - MP) & 1023) : (m & 255), T = smp ? 1024 : 256; const bool hp = t > 0, hn = t < T - 1; float v[8];
#pragma unroll
            for (int s = 0; s < 4; ++s) { mixed8(PQR, mu, m, 1792 + 32 * s + 8 * q, hp, hn, v);
#pragma unroll
                for (int j = 0; j < 8; ++j) v[j] = sigm(v[j]);
                Ag[s] = pack8(v); } }
#pragma unroll 2
          for (int cb = 0; cb < 32; ++cb) { const int c = 16 * cb + col; f32x4 accg = {0.f, 0.f, 0.f, 0.f};
#pragma unroll
              for (int s = 0; s < 4; ++s) { const bf16x8 bg = *(const bf16x8*)(G2T + (size_t)c * 128 + 32 * s + 8 * q); accg = __builtin_amdgcn_mfma_f32_16x16x32_bf16(Ag[s], bg, accg, 0, 0, 0); }
#pragma unroll
              for (int j = 0; j < 4; ++j) B.G[(size_t)(tok0 + 4 * q + j) * 512 + c] = (bf16)f2bf(accg[j]); } }
    }
}
template <int DV> __device__ __forceinline__ void attn_row(const bf16* q, const bf16* K, const bf16* V, int nk, int lane, float (&O)[DV / 64], float& lsum) {
    float qf[64];
#pragma unroll
    for (int i = 0; i < 8; ++i) { const v4u w = *(const v4u*)(q + 8 * i);
#pragma unroll
        for (int j = 0; j < 4; ++j) { qf[8 * i + 2 * j] = bflo(w[j]); qf[8 * i + 2 * j + 1] = bfhi(w[j]); } }
    float mrun = -INFINITY; lsum = 0.f;
#pragma unroll
    for (int j = 0; j < DV / 64; ++j) O[j] = 0.f;
    for (int kt = 0; kt < nk; kt += 64) {
        const bf16* kr = K + (size_t)(kt + lane) * 64; float s = 0.f;
#pragma unroll
        for (int i = 0; i < 8; ++i) { const v4u w = *(const v4u*)(kr + 8 * i);
#pragma unroll
            for (int j = 0; j < 4; ++j) { s += qf[8 * i + 2 * j] * bflo(w[j]); s += qf[8 * i + 2 * j + 1] * bfhi(w[j]); } }
        const float mnew = fmaxf(mrun, wave_max(s)); const float p = exp2f(s - mnew), corr = exp2f(mrun - mnew);
        lsum = lsum * corr + wave_sum(p); mrun = mnew;
#pragma unroll
        for (int j = 0; j < DV / 64; ++j) O[j] *= corr;
        const bf16* vr = V + (size_t)kt * DV + lane;
#pragma unroll 16
        for (int kk = 0; kk < 64; ++kk) { const float pk = __shfl(p, kk);
#pragma unroll
            for (int j = 0; j < DV / 64; ++j) O[j] += pk * bf1(vr[(size_t)kk * DV + 64 * j]); }
    }
}
__device__ __forceinline__ void phase_attn_naive(const Frame& F, int l) {
    const bf16* QA = (const bf16*)(F.big + B_QA); const bf16* QB = (const bf16*)(F.big + B_QB); const bf16* KA = (const bf16*)(F.big + B_KA); const bf16* VA = (const bf16*)(F.big + B_VA);
    const bf16* KB = (const bf16*)(F.big + B_KB); const bf16* VB = (const bf16*)(F.big + B_VB); bf16* OA = (bf16*)(F.big + B_OA); bf16* OB = (bf16*)(F.big + B_OB);
    const float lam = ((const float*)(F.ws + WS_LAM))[l]; const float lam_init = 0.8f - 0.6f * __expf(-0.3f * (float)l);
    const int lane = F.lane;
    for (int task = F.gw; task < M * 12; task += F.NGW) {
        const int m = M - 1 - task / 12, item = task % 12;
        const bool smp = m >= MP; const int seq = smp ? 32 + ((m - MP) >> 10) : (m >> 8); const int nk = smp ? 1280 : 256; const size_t kb = key_base(seq);
        if (item < 8) { float O[1], ls; attn_row<64>(QA + (size_t)m * 512 + item * 64, KA + ((size_t)(item >> 2) * NKEYS + kb) * 64, VA + ((size_t)(item >> 2) * NKEYS + kb) * 64, nk, lane, O, ls);
            OA[(size_t)m * 512 + item * 64 + lane] = (bf16)f2bf(O[0] / ls); }
        else { const int h = item - 8; float O1[2], O2[2], l1, l2;
            attn_row<128>(QB + (size_t)m * 512 + h * 128, KB + ((size_t)(h * 2 + 0) * NKEYS + kb) * 64, VB + ((size_t)h * NKEYS + kb) * 128, nk, lane, O1, l1);
            attn_row<128>(QB + (size_t)m * 512 + h * 128 + 64, KB + ((size_t)(h * 2 + 1) * NKEYS + kb) * 64, VB + ((size_t)h * NKEYS + kb) * 128, nk, lane, O2, l2);
            const float o0 = O1[0] / l1 - lam * O2[0] / l2, o1 = O1[1] / l1 - lam * O2[1] / l2;
            const float rn = rsqrtf(wave_sum(o0 * o0 + o1 * o1) * (1.0f / 128.0f) + RMS_EPS) * (1.0f - lam_init);
            const float* sg = F.a->in[18] + (size_t)l * 128;
            OB[(size_t)m * 512 + h * 128 + lane] = (bf16)f2bf(o0 * rn * sg[lane]); OB[(size_t)m * 512 + h * 128 + 64 + lane] = (bf16)f2bf(o1 * rn * sg[64 + lane]); }
    }
}
__device__ __forceinline__ void unpack4(unsigned long long w, float (&o)[4]) { const unsigned lo = (unsigned)w, hi = (unsigned)(w >> 32); o[0] = bflo(lo); o[1] = bfhi(lo); o[2] = bflo(hi); o[3] = bfhi(hi); }
__device__ __forceinline__ void phase_scan(const Frame& F, int l) {
    const RwkvBufs B = rwkv_bufs(F); bf16* OFW = (bf16*)(F.big + B_OF); bf16* OBW = (bf16*)(F.big + B_OBW);
    const int lane = F.lane, i = lane & 15, rl = lane >> 4;
    for (int task = F.gw; task < 1024 + 8192; task += F.NGW) {
        const bool smp = task < 1024; const int tt = smp ? task : task - 1024; const int sq = tt >> 8, h = (tt >> 5) & 7, dir = (tt >> 4) & 1, rg = tt & 15;
        const int T = smp ? 1024 : 256, m0 = smp ? MP + 1024 * sq : 256 * sq, row = 4 * rg + rl;
        float S[4] = {0.f, 0.f, 0.f, 0.f};
        if (smp) { const f32x4 s0 = *(const f32x4*)(F.a->in[6] + ((size_t)(((sq * 2 + l) * 2 + dir) * 8 + h) * 64 + row) * 64 + 4 * i); S[0] = s0[0]; S[1] = s0[1]; S[2] = s0[2]; S[3] = s0[3]; }
        const f32x4 ka4 = *(const f32x4*)(F.a->in[26] + (size_t)l * 512 + h * 64 + 4 * i);
        const bf16* SA = dir ? B.SA1 : B.SA0; const _Float16* SW = dir ? B.SW1 : B.SW0; bf16* OUT = dir ? OBW : OFW;
        for (int st = 0; st < T; ++st) {
            const int t = dir ? T - 1 - st : st; const size_t o = (size_t)(m0 + t) * 512 + h * 64;
            float r[4], k[4], kk[4], a[4], w[4];
            unpack4(*(const unsigned long long*)(B.SR + o + 4 * i), r); unpack4(*(const unsigned long long*)(B.SK + o + 4 * i), k); unpack4(*(const unsigned long long*)(B.SKK + o + 4 * i), kk);
            unpack4(*(const unsigned long long*)(SA + o + 4 * i), a);
            { typedef _Float16 h4 __attribute__((ext_vector_type(4))); const h4 wv = *(const h4*)(SW + o + 4 * i); w[0] = (float)wv[0]; w[1] = (float)wv[1]; w[2] = (float)wv[2]; w[3] = (float)wv[3]; }
            const float vv = bf1(B.SV[o + row]);
            float sa = 0.f;
#pragma unroll
            for (int c = 0; c < 4; ++c) sa -= S[c] * kk[c];
            sa = red16(sa);
            float ov = 0.f;
#pragma unroll
            for (int c = 0; c < 4; ++c) { const float kh = k[c] * (1.0f + (a[c] - 1.0f) * ka4[c]); S[c] = S[c] * w[c] + sa * (kk[c] * a[c]) + vv * kh; ov += S[c] * r[c]; }
            ov = red16(ov);
            if (i == 0) OUT[o + row] = (bf16)f2bf(ov);
        }
        if (!smp) *(f32x4*)(F.out + O_NST + ((size_t)(((sq * 2 + l) * 2 + dir) * 8 + h) * 64 + row) * 64 + 4 * i) = (f32x4){S[0], S[1], S[2], S[3]};
    }
}
__device__ __forceinline__ void phase_rwkvpost(const Frame& F, int l) {
    const RwkvBufs B = rwkv_bufs(F); const bf16* OFW = (const bf16*)(F.big + B_OF); const bf16* OBW = (const bf16*)(F.big + B_OBW); bf16* OC = (bf16*)(F.big + B_OC);
    const int lane = F.lane; const float* gng = F.a->in[28] + (size_t)l * 512 + 8 * lane; const float* gnb = F.a->in[29] + (size_t)l * 512 + 8 * lane;
    for (int m = F.gw; m < M; m += F.NGW) {
        const size_t o = (size_t)m * 512 + 8 * lane;
        const v4u a = *(const v4u*)(OFW + o), b = *(const v4u*)(OBW + o), vv = *(const v4u*)(B.SV + o), gg = *(const v4u*)(B.G + o);
        float x[8]; float s = 0.f;
#pragma unroll
        for (int j = 0; j < 4; ++j) { x[2 * j] = bflo(a[j]) + bflo(b[j]); x[2 * j + 1] = bfhi(a[j]) + bfhi(b[j]); s += x[2 * j] + x[2 * j + 1]; }
        s += __shfl_xor(s, 1); s += __shfl_xor(s, 2); s += __shfl_xor(s, 4); const float mean = s * (1.0f / 64.0f); float q = 0.f;
#pragma unroll
        for (int j = 0; j < 8; ++j) { x[j] -= mean; q += x[j] * x[j]; }
        q += __shfl_xor(q, 1); q += __shfl_xor(q, 2); q += __shfl_xor(q, 4); const float rstd = rsqrtf(q * (1.0f / 64.0f) + GN_EPS);
        const float bon = B.BON[(size_t)m * 8 + (lane >> 3)]; float y[8];
#pragma unroll
        for (int j = 0; j < 4; ++j) { const float v0 = bflo(vv[j]), v1 = bfhi(vv[j]), g0 = bflo(gg[j]), g1 = bfhi(gg[j]);
            y[2 * j] = (x[2 * j] * rstd * gng[2 * j] + gnb[2 * j] + bon * v0) * g0; y[2 * j + 1] = (x[2 * j + 1] * rstd * gng[2 * j + 1] + gnb[2 * j + 1] + bon * v1) * g1; }
        v4u w; w.x = pk2(y[0], y[1]); w.y = pk2(y[2], y[3]); w.z = pk2(y[4], y[5]); w.w = pk2(y[6], y[7]); *(v4u*)(OC + o) = w;
    }
}
typedef float f32x16 __attribute__((ext_vector_type(16)));
typedef short s16x4 __attribute__((ext_vector_type(4)));
typedef short v4i16_t __attribute__((ext_vector_type(4)));
constexpr int AT_KST = 144;
template <int DV> struct AttnLds { static constexpr int VST = DV * 2 + 16, KBYTES = 64 * AT_KST, VBYTES = 64 * VST, BUF = KBYTES + VBYTES; };
__device__ __forceinline__ float pl32_max(float m) { auto rr = __builtin_amdgcn_permlane32_swap(__float_as_uint(m), __float_as_uint(m), false, false); return fmaxf(__uint_as_float(rr[0]), __uint_as_float(rr[1])); }
__device__ __forceinline__ float pl32_sum(float m) { auto rr = __builtin_amdgcn_permlane32_swap(__float_as_uint(m), __float_as_uint(m), false, false); return __uint_as_float(rr[0]) + __uint_as_float(rr[1]); }
template <int DV> __device__ __forceinline__ void attn_stream(const Frame& F, const bf16x8 (&qf)[4], const bf16* K, const bf16* V, int nk, f32x16 (&o)[DV / 32], float& lsum_out) {
    typedef AttnLds<DV> L; constexpr int NV = DV / 64;
    const int tid = F.tid, lane = F.lane, r32 = lane & 31, hi = lane >> 5;
    LAS unsigned char* lds = F.lds;
    const int krow = tid >> 3, kch = tid & 7;
    const bf16* kg = K + (size_t)krow * 64 + kch * 8; const int klds = krow * AT_KST + kch * 16;
    int vlds[NV]; const bf16* vg[NV];
#pragma unroll
    for (int i = 0; i < NV; ++i) { const int idx = tid + 512 * i, row = idx / (DV / 8), ch = idx % (DV / 8); vg[i] = V + (size_t)row * DV + ch * 8; vlds[i] = L::KBYTES + row * L::VST + ch * 16; }
    const int kfo = r32 * AT_KST + hi * 16;
    const int vfo = L::KBYTES + (4 * hi + ((lane & 15) >> 2)) * L::VST + (((lane >> 4) & 1) * 16 + (lane & 3) * 4) * 2;
#pragma unroll
    for (int d = 0; d < DV / 32; ++d) o[d] = (f32x16){0.f, 0.f, 0.f, 0.f, 0.f, 0.f, 0.f, 0.f, 0.f, 0.f, 0.f, 0.f, 0.f, 0.f, 0.f, 0.f};
    float mrun = -INFINITY, lsum = 0.f;
    const int nt = nk >> 6;
    v4u kreg, vreg[NV];
    kreg = *(const v4u*)kg;
#pragma unroll
    for (int i = 0; i < NV; ++i) vreg[i] = *(const v4u*)vg[i];
    *(LAS v4u*)(lds + klds) = kreg;
#pragma unroll
    for (int i = 0; i < NV; ++i) *(LAS v4u*)(lds + vlds[i]) = vreg[i];
    __syncthreads();
    for (int t = 0; t < nt; ++t) {
        const int bo = (t & 1) * L::BUF, bn = ((t + 1) & 1) * L::BUF;
        if (t + 1 < nt) { kreg = *(const v4u*)(kg + (size_t)(t + 1) * 64 * 64);
#pragma unroll
            for (int i = 0; i < NV; ++i) vreg[i] = *(const v4u*)(vg[i] + (size_t)(t + 1) * 64 * DV); }
        f32x16 p0 = (f32x16){0.f, 0.f, 0.f, 0.f, 0.f, 0.f, 0.f, 0.f, 0.f, 0.f, 0.f, 0.f, 0.f, 0.f, 0.f, 0.f}, p1 = p0;
#pragma unroll
        for (int s = 0; s < 4; ++s) {
            const bf16x8 k0 = *(const LAS bf16x8*)(lds + bo + kfo + s * 32), k1 = *(const LAS bf16x8*)(lds + bo + kfo + 32 * AT_KST + s * 32);
            p0 = __builtin_amdgcn_mfma_f32_32x32x16_bf16(k0, qf[s], p0, 0, 0, 0); p1 = __builtin_amdgcn_mfma_f32_32x32x16_bf16(k1, qf[s], p1, 0, 0, 0); }
        float mx = fmaxf(p0[0], p1[0]);
#pragma unroll
        for (int r = 1; r < 16; ++r) mx = fmaxf(mx, fmaxf(p0[r], p1[r]));
        mx = pl32_max(mx);
        const float mnew = fmaxf(mrun, mx), corr = __builtin_amdgcn_exp2f(mrun - mnew); mrun = mnew;
        float ps = 0.f;
#pragma unroll
        for (int r = 0; r < 16; ++r) { p0[r] = __builtin_amdgcn_exp2f(p0[r] - mnew); p1[r] = __builtin_amdgcn_exp2f(p1[r] - mnew); ps += p0[r] + p1[r]; }
        lsum = lsum * corr + ps;
#pragma unroll
        for (int d = 0; d < DV / 32; ++d) o[d] *= corr;
#pragma unroll
        for (int hf = 0; hf < 2; ++hf)
#pragma unroll
            for (int s2 = 0; s2 < 2; ++s2) {
                v4u w; const f32x16& ph = hf ? p1 : p0;
                w.x = pg8::cvt_pk_bf16(ph[8 * s2 + 0], ph[8 * s2 + 1]); w.y = pg8::cvt_pk_bf16(ph[8 * s2 + 2], ph[8 * s2 + 3]); w.z = pg8::cvt_pk_bf16(ph[8 * s2 + 4], ph[8 * s2 + 5]); w.w = pg8::cvt_pk_bf16(ph[8 * s2 + 6], ph[8 * s2 + 7]);
                const bf16x8 pb = __builtin_bit_cast(bf16x8, w);
#pragma unroll
                for (int d = 0; d < DV / 32; ++d) {
                    const int off = bo + vfo + (32 * hf + 16 * s2) * L::VST + d * 64;
                    const s16x4 lo = __builtin_bit_cast(s16x4, __builtin_amdgcn_ds_read_tr16_b64_v4i16((LAS v4i16_t*)(lds + off)));
                    const s16x4 hh = __builtin_bit_cast(s16x4, __builtin_amdgcn_ds_read_tr16_b64_v4i16((LAS v4i16_t*)(lds + off + 8 * L::VST)));
                    const bf16x8 va = (bf16x8){lo[0], lo[1], lo[2], lo[3], hh[0], hh[1], hh[2], hh[3]};
                    o[d] = __builtin_amdgcn_mfma_f32_32x32x16_bf16(va, pb, o[d], 0, 0, 0); } }
        if (t + 1 < nt) { *(LAS v4u*)(lds + bn + klds) = kreg;
#pragma unroll
            for (int i = 0; i < NV; ++i) *(LAS v4u*)(lds + bn + vlds[i]) = vreg[i]; }
        __syncthreads();
    }
    lsum_out = pl32_sum(lsum);
}
__device__ __forceinline__ void load_qf(const bf16* Q  , int lane, bf16x8 (&qf)[4]) {
    const bf16* p = Q + (size_t)(lane & 31) * 512 + (lane >> 5) * 8;
#pragma unroll
    for (int s = 0; s < 4; ++s) qf[s] = *(const bf16x8*)(p + 16 * s);
}
__device__ __forceinline__ void attn_unit_a(const Frame& F, int seq, int hq, int qb) {
    const bf16* QA = (const bf16*)(F.big + B_QA); const bf16* KA = (const bf16*)(F.big + B_KA); const bf16* VA = (const bf16*)(F.big + B_VA); bf16* OA = (bf16*)(F.big + B_OA);
    const bool smp = seq >= 32; const int nk = smp ? 1280 : 256; const size_t kb = key_base(seq); const int m0 = (smp ? MP + 1024 * (seq - 32) : 256 * seq) + 256 * qb + 32 * F.wave;
    bf16x8 qf[4]; load_qf(QA + (size_t)m0 * 512 + hq * 64, F.lane, qf);
    f32x16 o[2]; float ls;
    attn_stream<64>(F, qf, KA + ((size_t)(hq >> 2) * NKEYS + kb) * 64, VA + ((size_t)(hq >> 2) * NKEYS + kb) * 64, nk, o, ls);
    const float rl = 1.0f / ls; const int hi = F.lane >> 5; bf16* op = OA + (size_t)(m0 + (F.lane & 31)) * 512 + hq * 64 + 4 * hi;
#pragma unroll
    for (int d = 0; d < 2; ++d)
#pragma unroll
        for (int g = 0; g < 4; ++g) { unsigned long long w = (unsigned long long)pk2(o[d][4 * g] * rl, o[d][4 * g + 1] * rl) | ((unsigned long long)pk2(o[d][4 * g + 2] * rl, o[d][4 * g + 3] * rl) << 32);
            *(unsigned long long*)(op + 32 * d + 8 * g) = w; }
}
__device__ __forceinline__ void attn_unit_b(const Frame& F, int l, int seq, int h, int qb) {
    const bf16* QB = (const bf16*)(F.big + B_QB); const bf16* KB = (const bf16*)(F.big + B_KB); const bf16* VB = (const bf16*)(F.big + B_VB); bf16* OB = (bf16*)(F.big + B_OB);
    const bool smp = seq >= 32; const int nk = smp ? 1280 : 256; const size_t kb = key_base(seq); const int m0 = (smp ? MP + 1024 * (seq - 32) : 256 * seq) + 256 * qb + 32 * F.wave;
    const float lam = ((const float*)(F.ws + WS_LAM))[l], lam_init = 0.8f - 0.6f * __expf(-0.3f * (float)l);
    bf16x8 qf[4]; float l1, l2; LAS v4u* o1l = (LAS v4u*)(F.lds + 2 * AttnLds<128>::BUF + F.wave * 8192) + F.lane;
    { f32x16 o1[4];
      load_qf(QB + (size_t)m0 * 512 + h * 128, F.lane, qf);
      attn_stream<128>(F, qf, KB + ((size_t)(h * 2 + 0) * NKEYS + kb) * 64, VB + ((size_t)h * NKEYS + kb) * 128, nk, o1, l1);
      const float r1 = 1.0f / l1;
#pragma unroll
      for (int d = 0; d < 4; ++d)
#pragma unroll
          for (int j = 0; j < 2; ++j) { v4u w; w.x = pg8::cvt_pk_bf16(o1[d][8 * j] * r1, o1[d][8 * j + 1] * r1); w.y = pg8::cvt_pk_bf16(o1[d][8 * j + 2] * r1, o1[d][8 * j + 3] * r1);
              w.z = pg8::cvt_pk_bf16(o1[d][8 * j + 4] * r1, o1[d][8 * j + 5] * r1); w.w = pg8::cvt_pk_bf16(o1[d][8 * j + 6] * r1, o1[d][8 * j + 7] * r1); o1l[(2 * d + j) * 64] = w; } }
    f32x16 o1[4];
    { f32x16 o2[4];
      load_qf(QB + (size_t)m0 * 512 + h * 128 + 64, F.lane, qf);
      attn_stream<128>(F, qf, KB + ((size_t)(h * 2 + 1) * NKEYS + kb) * 64, VB + ((size_t)h * NKEYS + kb) * 128, nk, o2, l2);
      const float r2 = lam / l2;
#pragma unroll
      for (int d = 0; d < 4; ++d)
#pragma unroll
          for (int j = 0; j < 2; ++j) { const v4u w = o1l[(2 * d + j) * 64];
#pragma unroll
              for (int e = 0; e < 4; ++e) { o1[d][8 * j + 2 * e] = bflo(w[e]) - o2[d][8 * j + 2 * e] * r2; o1[d][8 * j + 2 * e + 1] = bfhi(w[e]) - o2[d][8 * j + 2 * e + 1] * r2; } } }
    float ss = 0.f;
#pragma unroll
    for (int d = 0; d < 4; ++d)
#pragma unroll
        for (int r = 0; r < 16; ++r) ss += o1[d][r] * o1[d][r];
    const float rn = rsqrtf(pl32_sum(ss) * (1.0f / 128.0f) + RMS_EPS) * (1.0f - lam_init);
    const int hi = F.lane >> 5; const float* sg = F.a->in[18] + (size_t)l * 128 + 4 * hi; bf16* op = OB + (size_t)(m0 + (F.lane & 31)) * 512 + h * 128 + 4 * hi;
#pragma unroll
    for (int d = 0; d < 4; ++d)
#pragma unroll
        for (int g = 0; g < 4; ++g) { const f32x4 gv = *(const f32x4*)(sg + 32 * d + 8 * g);
            unsigned long long w = (unsigned long long)pk2(o1[d][4 * g] * rn * gv[0], o1[d][4 * g + 1] * rn * gv[1]) | ((unsigned long long)pk2(o1[d][4 * g + 2] * rn * gv[2], o1[d][4 * g + 3] * rn * gv[3]) << 32);
            *(unsigned long long*)(op + 32 * d + 8 * g) = w; }
}
typedef float f32x2 __attribute__((ext_vector_type(2)));
constexpr int SC_CH = 32, SC_STEP = 1536, SC_BUF = SC_CH * SC_STEP, SC_OUT = 2 * SC_BUF, SC_OUTB = SC_CH * 64 * 4;
template <int N> __device__ __forceinline__ float dpp_ror_add(float v) {
    return v + __int_as_float(__builtin_amdgcn_update_dpp(0, __float_as_int(v), 0x120 + N, 0xf, 0xf, false));
}
__device__ __forceinline__ float red16_dpp(float v) { v = dpp_ror_add<8>(v); v = dpp_ror_add<4>(v); v = dpp_ror_add<2>(v); v = dpp_ror_add<1>(v); return v; }
struct ScanPre { unsigned long long r, k, kk, a, w, v; };
__device__ __forceinline__ void scan_task(const Frame& F, int l, int seq, int h, int dir) {
    const RwkvBufs B = rwkv_bufs(F); bf16* OUT = (bf16*)(F.big + (dir ? B_OBW : B_OF));
    const bf16* SA = dir ? B.SA1 : B.SA0; const _Float16* SW = dir ? B.SW1 : B.SW0;
    const bool smp = seq >= 32; const int T = smp ? 1024 : 256, m0 = smp ? MP + 1024 * (seq - 32) : 256 * seq;
    const int tid = F.tid, lane = F.lane, i = lane & 15, rl = lane >> 4, row0 = 8 * F.wave + 2 * rl;
    LAS unsigned char* lds = F.lds;
    const int sl = tid >> 4, cc = tid & 15; const f32x4 ka4 = *(const f32x4*)(F.a->in[26] + (size_t)l * 512 + h * 64 + 4 * cc);
    f32x2 S[2][2];
    if (smp) { const float* sp = F.a->in[6] + ((size_t)((((seq - 32) * 2 + l) * 2 + dir) * 8 + h) * 64 + row0) * 64 + 4 * i;
        const f32x4 a = *(const f32x4*)sp, b = *(const f32x4*)(sp + 64); S[0][0] = (f32x2){a[0], a[1]}; S[0][1] = (f32x2){a[2], a[3]}; S[1][0] = (f32x2){b[0], b[1]}; S[1][1] = (f32x2){b[2], b[3]}; }
    else { S[0][0] = S[0][1] = S[1][0] = S[1][1] = (f32x2){0.f, 0.f}; }
    const int nch = T / SC_CH;
    ScanPre pre;
#define SC_LOAD(c) do { const int st_ = (c) * SC_CH + sl; const int t_ = dir ? T - 1 - st_ : st_; const size_t o_ = (size_t)(m0 + t_) * 512 + h * 64 + 4 * cc; \
        pre.r = *(const unsigned long long*)(B.SR + o_); pre.k = *(const unsigned long long*)(B.SK + o_); pre.kk = *(const unsigned long long*)(B.SKK + o_); \
        pre.a = *(const unsigned long long*)(SA + o_); pre.w = *(const unsigned long long*)(SW + o_); pre.v = *(const unsigned long long*)(B.SV + o_); } while (0)
#define SC_STAGE(bufoff) do { float r_[4], k_[4], kk_[4], a_[4], v_[4]; unpack4(pre.r, r_); unpack4(pre.k, k_); unpack4(pre.kk, kk_); unpack4(pre.a, a_); unpack4(pre.v, v_); \
        typedef _Float16 h4_ __attribute__((ext_vector_type(4))); const h4_ wv_ = __builtin_bit_cast(h4_, pre.w); f32x4 w4_, kka_, kh_; \
        _Pragma("unroll") for (int c_ = 0; c_ < 4; ++c_) { w4_[c_] = (float)wv_[c_]; kka_[c_] = kk_[c_] * a_[c_]; kh_[c_] = k_[c_] * (1.0f + (a_[c_] - 1.0f) * ka4[c_]); } \
        LAS unsigned char* d_ = lds + (bufoff) + sl * SC_STEP + cc * 16; \
        *(LAS f32x4*)(d_) = (f32x4){r_[0], r_[1], r_[2], r_[3]}; *(LAS f32x4*)(d_ + 256) = w4_; *(LAS f32x4*)(d_ + 512) = (f32x4){kk_[0], kk_[1], kk_[2], kk_[3]}; \
        *(LAS f32x4*)(d_ + 768) = kka_; *(LAS f32x4*)(d_ + 1024) = kh_; *(LAS f32x4*)(d_ + 1280) = (f32x4){v_[0], v_[1], v_[2], v_[3]}; } while (0)
    SC_LOAD(0); SC_STAGE(0);
    __syncthreads();
    for (int c = 0; c < nch; ++c) {
        const int bo = (c & 1) * SC_BUF, bn = ((c + 1) & 1) * SC_BUF; LAS float* outl = (LAS float*)(lds + SC_OUT + (c & 1) * SC_OUTB);
        if (c + 1 < nch) SC_LOAD(c + 1);
#pragma unroll 4
        for (int s = 0; s < SC_CH; ++s) {
            const LAS unsigned char* p = lds + bo + s * SC_STEP + i * 16;
            const f32x4 r4 = *(const LAS f32x4*)p, w4 = *(const LAS f32x4*)(p + 256), kk4 = *(const LAS f32x4*)(p + 512), kka4 = *(const LAS f32x4*)(p + 768), kh4 = *(const LAS f32x4*)(p + 1024);
            const f32x2 vv = *(const LAS f32x2*)(lds + bo + s * SC_STEP + 1280 + row0 * 4);
            const f32x2 r01 = {r4[0], r4[1]}, r23 = {r4[2], r4[3]}, w01 = {w4[0], w4[1]}, w23 = {w4[2], w4[3]}, k01 = {kk4[0], kk4[1]}, k23 = {kk4[2], kk4[3]};
            const f32x2 a01 = {kka4[0], kka4[1]}, a23 = {kka4[2], kka4[3]}, h01 = {kh4[0], kh4[1]}, h23 = {kh4[2], kh4[3]};
#pragma unroll
            for (int rr = 0; rr < 2; ++rr) {
                f32x2 d = S[rr][0] * k01; d = __builtin_elementwise_fma(S[rr][1], k23, d);
                const float sa = -red16_dpp(d[0] + d[1]); const float vr = rr ? vv[1] : vv[0];
                const f32x2 sa2 = {sa, sa}, v2 = {vr, vr};
                S[rr][0] = __builtin_elementwise_fma(sa2, a01, __builtin_elementwise_fma(v2, h01, S[rr][0] * w01));
                S[rr][1] = __builtin_elementwise_fma(sa2, a23, __builtin_elementwise_fma(v2, h23, S[rr][1] * w23));
                f32x2 od = S[rr][0] * r01; od = __builtin_elementwise_fma(S[rr][1], r23, od);
                const float ov = red16_dpp(od[0] + od[1]);
                if (i == 0) outl[s * 64 + row0 + rr] = ov;
            }
        }
        if (c + 1 < nch) SC_STAGE(bn);
        __syncthreads();
        { const f32x4 ov4 = *(const LAS f32x4*)(outl + sl * 64 + 4 * cc); const int st = c * SC_CH + sl, t = dir ? T - 1 - st : st;
          *(unsigned long long*)(OUT + (size_t)(m0 + t) * 512 + h * 64 + 4 * cc) = (unsigned long long)pk2(ov4[0], ov4[1]) | ((unsigned long long)pk2(ov4[2], ov4[3]) << 32); }
    }
#undef SC_LOAD
#undef SC_STAGE
    if (!smp) { float* sp = F.out + O_NST + ((size_t)(((seq * 2 + l) * 2 + dir) * 8 + h) * 64 + row0) * 64 + 4 * i;
        *(f32x4*)sp = (f32x4){S[0][0][0], S[0][0][1], S[0][1][0], S[0][1][1]}; *(f32x4*)(sp + 64) = (f32x4){S[1][0][0], S[1][0][1], S[1][1][0], S[1][1][1]}; }
    __syncthreads();
}
constexpr int CW_QUEUE = 2048;
constexpr int QT0 = 64, QT1 = QT0 + 64, QT2 = QT1 + 128, QT3 = QT2 + 512, QT4 = QT3 + 128, QT5 = QT4 + 256;
#ifndef MIX_DYN
#define MIX_DYN 1
#endif
#ifndef MIX_ATT
#define MIX_ATT 1
#endif
#ifndef MIX_SCAN
#define MIX_SCAN 1
#endif
__device__ __forceinline__ void phase_mixer(const Frame& F, int l) {
    unsigned* ctr = (unsigned*)(F.ws + WS_CTL) + CW_QUEUE + 64 * l; volatile LAS unsigned* slot = (volatile LAS unsigned*)(F.lds + MISC_OFF) + 16;
#if MIX_DYN
    for (;;) {
        __syncthreads();
        if (F.tid == 0) slot[0] = __hip_atomic_fetch_add(ctr, 1u, __ATOMIC_RELAXED, __HIP_MEMORY_SCOPE_AGENT);
        __syncthreads();
        const int task = (int)slot[0];
        if (task >= QT5) break;
#else
    for (int task = F.bid; task < QT5; task += F.G) {
        __syncthreads();
#endif
        if (task < QT0) { if (MIX_SCAN) scan_task(F, l, 32 + (task >> 4), (task >> 1) & 7, task & 1); }
        else if (task < QT1) { const int u = task - QT0; if (MIX_ATT) attn_unit_b(F, l, 32 + (u >> 4), (u >> 2) & 3, u & 3); }
        else if (task < QT2) { const int u = task - QT1; if (MIX_ATT) attn_unit_a(F, 32 + (u >> 5), (u >> 2) & 7, u & 3); }
        else if (task < QT3) { const int u = task - QT2; if (MIX_SCAN) scan_task(F, l, u >> 4, (u >> 1) & 7, u & 1); }
        else if (task < QT4) { const int u = task - QT3; if (MIX_ATT) attn_unit_b(F, l, u >> 2, u & 3, 0); }
        else { const int u = task - QT4; if (MIX_ATT) attn_unit_a(F, u >> 3, u & 7, 0); }
    }
    if (!MIX_SCAN) phase_scan(F, l);
    if (!MIX_ATT) phase_attn_naive(F, l);
}
constexpr int PH_PER_LAYER = 16, N_PHASES = 2 + NL * PH_PER_LAYER;
template <class Epi> __device__ __forceinline__ void run_gemm(const Frame& F, const bf16* A, const bf16* Bt, int N, int K, const Epi& E) {
    pg8::Gemm g{A, Bt, M, N, K}; pg8::StaticOrder S; S.init(M, N, F.G, F.bid);
    pg8::gemm_phase<Epi, pg8::StaticOrder, true, true>(F.lds + RING_OFF, g, S, E);
}
#ifndef PHMASK
#define PHMASK 0xffff
#endif
#define PHON(k) ((PHMASK >> (k)) & 1)
__device__ __forceinline__ void run_phase(const Frame& F, int ph) {
    if (ph == 0) { if (PHON(0)) phase_conv(F); return; }
    if (ph == 1) { if (PHON(1)) phase_init(F); return; }
    const int l = (ph - 2) / PH_PER_LAYER, s = (ph - 2) % PH_PER_LAYER;
    bf16* wl = wlayer(F, l); const bf16* H = (const bf16*)(F.ws + WS_H);
    if (PHON(2) && (s == 0 || s == 13)) { pg8::EpiSwiglu E{(bf16*)(F.big + B_ACT), FF}; run_gemm(F, H, wl + (s ? WL_W2A : WL_W1A), 2 * FF, DM, E); }
    else if (PHON(3) && (s == 1 || s == 11 || s == 14)) {
        const bf16* A = s == 11 ? (const bf16*)(F.big + B_GU) : (const bf16*)(F.big + B_ACT); const int K = s == 11 ? DM : FF;
        const bf16* Bt = wl + (s == 1 ? WL_W1B : s == 11 ? WL_WO : WL_W2B); pg8::EpiF32 E{(float*)(F.big + (s == 11 ? B_Z1 : B_Z2)), DM}; run_gemm(F, A, Bt, DM, K, E); }
    else if (PHON(4) && (s == 2 || s == 12 || s == 15)) { phase_ln(F, l, s == 2 ? 0 : s == 12 ? 1 : 2, (const float*)(F.big + (s == 12 ? B_Z1 : B_Z2))); }
    else if (PHON(5) && (s == 3 || s == 5 || s == 9)) {
        const int r0 = s == 3 ? WIN_ATT : s == 5 ? WIN_RWKV : WIN_GATE, N = s == 3 ? 2304 : s == 5 ? 2048 : 3072;
        pg8::EpiBf E{(bf16*)(F.big + (s == 3 ? B_PQA : s == 5 ? B_PQR : B_GATES)), N, s == 9 ? 1 : 0}; run_gemm(F, H, wl + WL_WIN + (size_t)r0 * DM, N, DM, E); }
    else if (PHON(6) && s == 4) phase_attprep(F, l);
    else if (PHON(7) && s == 6) phase_rwkvprep(F, l);
    else if (s == 7) {
#if MK_NAIVE_MIXER
        if (PHON(8)) phase_scan(F, l); if (PHON(9)) phase_attn_naive(F, l);
#else
        if (PHON(8)) phase_mixer(F, l);
#endif
    }
    else if (PHON(10) && s == 8) phase_rwkvpost(F, l);
    else if (PHON(11) && s == 10) {
        for (int i = 0; i < 3; ++i) { const bf16* A = (const bf16*)(F.big + (i == 0 ? B_OA : i == 1 ? B_OB : B_OC));
            pg8::EpiUp E{(const bf16*)(F.big + B_GATES), 3072, i * 1024, (float*)(F.big + B_T), (bf16*)(F.big + B_GU), i}; run_gemm(F, A, wl + WL_WUP + (size_t)i * 524288, DM, 512, E); } }
}
__global__ void __launch_bounds__(NWAVES * 64, 2) fwd(Args args) {
    extern __shared__ __attribute__((aligned(16))) unsigned char lds[];
    Frame F;
    F.lds = (LAS unsigned char*)lds; F.tid = threadIdx.x; F.lane = F.tid & 63; F.wave = __builtin_amdgcn_readfirstlane(F.tid >> 6);
    F.G = gridDim.x; F.bid = blockIdx.x; F.gw = F.bid * NWAVES + F.wave; F.NGW = F.G * NWAVES;
    F.a = &args;
    F.out = args.out; F.ws = args.ws; F.big = args.ws + WS_BIG;
    for (int u = F.tid; u < (LDS_BYTES - LDSCTL_OFF) / 4; u += NWAVES * 64) ((LAS unsigned*)(F.lds + LDSCTL_OFF))[u] = 0u;
    __syncthreads();
    const int lo = args.ph_lo, hi = args.ph_hi;
    XcdBarrier bar; bar.bar = (unsigned*)(args.ws + WS_CTL) + CW_BAR; bar.x = 0; bar.st = nullptr;
    if (hi - lo > 1) bar = xcd_barrier_post((unsigned*)(args.ws + WS_CTL) + CW_BAR, (volatile LAS unsigned*)(F.lds + MISC_OFF) + 8);
    for (int ph = lo; ph < hi; ++ph) {
        Frame FL = F;
        asm volatile("" : "+s"(FL.ws), "+s"(FL.big), "+s"(FL.out), "+v"(FL.lane), "+v"(FL.tid));
        run_phase(FL, ph);
#ifdef REPEAT_MASK
        { const int sx = ph < 2 ? ph : 2 + (ph - 2) % PH_PER_LAYER; if ((REPEAT_MASK >> sx) & 1) { __syncthreads(); if (hi - lo > 1) xcd_barrier(bar); run_phase(FL, ph); } }
#endif
        if (ph + 1 < hi) xcd_barrier(bar);
    }
}
extern "C" void kernel_launch(void* const* d_in, const int* in_sizes, int n_in, void* d_out, int out_size, void* d_ws, size_t ws_size, hipStream_t stream) {
    static int grid = 0;
    if (grid == 0) {
        if (n_in != 32 || out_size != (int)O_TOTAL || ws_size < WS_END) { fprintf(stderr, "kernel_launch: unexpected problem: n_in %d out %d ws %zu (need %zu)\n", n_in, out_size, ws_size, (size_t)WS_END); grid = -1; return; }
        int dev = 0, cus = 0, per_cu = 0;
        if (hipGetDevice(&dev) != hipSuccess || hipDeviceGetAttribute(&cus, hipDeviceAttributeMultiprocessorCount, dev) != hipSuccess) { grid = -1; return; }
        if (hipFuncSetAttribute((const void*)fwd, hipFuncAttributeMaxDynamicSharedMemorySize, LDS_BYTES) != hipSuccess) { fprintf(stderr, "kernel_launch: hipFuncSetAttribute failed\n"); grid = -1; return; }
        if (hipOccupancyMaxActiveBlocksPerMultiprocessor(&per_cu, (const void*)fwd, NWAVES * 64, LDS_BYTES) != hipSuccess || per_cu < 1) { fprintf(stderr, "kernel_launch: occupancy query says %d blocks per CU\n", per_cu); (void)hipGetLastError(); per_cu = 1; }
        grid = cus;
        if (grid > 256) grid = 256;
    }
    if (grid < 0) return;
    (void)hipMemsetAsync((char*)d_ws + WS_CTL, 0, CTL_ZERO_BYTES, stream);
    Args a{};
    for (int i = 0; i < 32; ++i) a.in[i] = (const float*)d_in[i];
    a.out = (float*)d_out; a.ws = (unsigned char*)d_ws;
#if MK_ONE_LAUNCH
    a.ph_lo = 0; a.ph_hi = N_PHASES;
    hipLaunchKernelGGL(fwd, dim3(grid), dim3(NWAVES * 64), LDS_BYTES, stream, a);
#else
    for (int ph = 0; ph < N_PHASES; ++ph) { a.ph_lo = ph; a.ph_hi = ph + 1; hipLaunchKernelGGL(fwd, dim3(grid), dim3(NWAVES * 64), LDS_BYTES, stream, a); }
#endif
}
```

```cpp
#include <hip/hip_runtime.h>
#include <cstdio>
#include <cstdint>
#ifndef MK_ONE_LAUNCH
#define MK_ONE_LAUNCH 1
#endif
#ifndef MK_NAIVE_MIXER
#define MK_NAIVE_MIXER 0
#endif
#define GAS __attribute__((address_space(1)))
#define LAS __attribute__((address_space(3)))
typedef unsigned short bf16;
typedef unsigned v4u __attribute__((ext_vector_type(4)));
typedef float f32x4 __attribute__((ext_vector_type(4)));
typedef short bf16x8 __attribute__((ext_vector_type(8)));
typedef GAS unsigned gu32;
typedef GAS unsigned long long gu64;
#define RLX_AGENT __ATOMIC_RELAXED, __HIP_MEMORY_SCOPE_AGENT
#define LDS_WAIT() asm volatile("s_waitcnt lgkmcnt(0)" ::: "memory")
#define VM_WAIT() asm volatile("s_waitcnt vmcnt(0)" ::: "memory")
__device__ __forceinline__ unsigned long long rt() { return __builtin_amdgcn_s_memrealtime(); }
__device__ __forceinline__ unsigned f2bf(float f) { return __builtin_bit_cast(unsigned short, (__bf16)f); }
typedef float f32x2_pk __attribute__((ext_vector_type(2))); typedef __bf16 bf16x2_pk __attribute__((ext_vector_type(2)));
__device__ __forceinline__ unsigned pk2(float lo, float hi) { f32x2_pk v = {lo, hi}; bf16x2_pk b = __builtin_convertvector(v, bf16x2_pk); return __builtin_bit_cast(unsigned, b); }
namespace pg8 {
#define PG8_LAS __attribute__((address_space(3)))
typedef unsigned short bf16_t;
typedef short bf16x8 __attribute__((ext_vector_type(8)));
typedef float f32x4 __attribute__((ext_vector_type(4)));
typedef unsigned u32x4 __attribute__((ext_vector_type(4)));
constexpr int BM = 256, BK = 64, HALF = 128, HTB = HALF * BK * 2  , STAGE_BYTES = 8 * HTB, NXCD = 8, WGM = 8;

__host__ __device__ __forceinline__ int lds_byte(int r, int c) { const int st = (r >> 4) * 2 + (c >> 5), rr = r & 15, cc = c & 31, ob = rr * 64 + cc * 2; return st * 1024 + (ob ^ (((ob >> 9) & 1) << 5)); }
__host__ __device__ __forceinline__ void stage_rc(int b, int& R, int& C) { const int st = b / 1024, sb = b % 1024, swz = sb ^ (((sb >> 9) & 1) << 5); R = (st >> 1) * 16 + swz / 64; C = (st & 1) * 32 + (swz % 64) / 2; }
__host__ __device__ __forceinline__ int perm32(int rho) { const int n = rho >> 4, i = rho & 15; return 8 * (i >> 2) + 4 * n + (i & 3); }

struct Unit { int pm, pn; };
struct Gemm { const bf16_t* A; const bf16_t* Bt; int M, N, K; };

struct StaticOrder {
    int nM, nN, nwg, G, c;
    __host__ __device__ void init(int M, int N, int G_, int c_) { nM = M / BM; nN = N / BM; nwg = nM * nN; G = G_; c = c_; }
    __host__ __device__ bool next(int i, Unit& u) const {
        const long L = (long)i * G + c; if (L >= nwg) return false;
        int wgid = (int)L; { const int q = nwg / NXCD, r = nwg % NXCD, xcd = wgid % NXCD, off = wgid / NXCD; wgid = (xcd < r ? xcd * (q + 1) : r * (q + 1) + (xcd - r) * q) + off; }
        const int nig = WGM * nN, gid = wgid / nig, fm = gid * WGM, gsz = (nM - fm) < WGM ? (nM - fm) : WGM;
        u.pm = fm + ((wgid % nig) % gsz); u.pn = (wgid % nig) / gsz; return true;
    }
    __device__ __forceinline__ void a_ready(const Unit&) const {}
    __device__ __forceinline__ void done(const Unit&) const {}
};

typedef float f32x2_cv __attribute__((ext_vector_type(2))); typedef __bf16 bf16x2_cv __attribute__((ext_vector_type(2)));
__device__ __forceinline__ unsigned cvt_pk_bf16(float lo, float hi) { f32x2_cv v = {lo, hi}; bf16x2_cv b = __builtin_convertvector(v, bf16x2_cv); return __builtin_bit_cast(unsigned, b); }
template <class Epi, class Sched, bool ALIGN_EPI = false, bool SP2 = false>
__device__ __forceinline__ void gemm_phase(PG8_LAS unsigned char* lds, const Gemm g, const Sched& S, const Epi& E) {
    int tid_ = threadIdx.x; asm volatile("" : "+v"(tid_));
    const int tid = tid_, wid = __builtin_amdgcn_readfirstlane(tid >> 6), lane = tid & 63, wr = wid >> 2, wc = wid & 3, fr = lane & 15, fq = lane >> 4;
    const int K = g.K, nt = K / BK;
    unsigned voffA[2], voffB[2];
#pragma unroll
    for (int i = 0; i < 2; ++i) { int R, C; stage_rc(tid * 16 + i * 8192, R, C); const int Rb = Epi::PERM ? ((R & ~31) + perm32(R & 31)) : R;
        voffA[i] = (unsigned)(R * K + C) * 2u; voffB[i] = (unsigned)(Rb * K + C) * 2u; }
    const size_t kstep = (size_t)(BK * 2);
    const size_t hstep = (size_t)HALF * K * 2;
    const size_t tstep = 2 * hstep;
    const unsigned ldsw = (unsigned)wid * 1024u;
    const int aoff = lds_byte(wr * 64 + fr, fq * 8), boff = lds_byte(wc * 32 + fr, fq * 8);
#define PG8_SA(b, h) (((b) * 2 + (h)) * HTB)
#define PG8_SB(b, h) ((4 + (b) * 2 + (h)) * HTB)
#define PG8_STAGE(bufoff, gbase, voff) do { _Pragma("unroll") for (int _i = 0; _i < 2; ++_i) \
        __builtin_amdgcn_global_load_lds((const unsigned*)((const char*)(gbase) + (voff)[_i]), (PG8_LAS unsigned*)(lds + (bufoff) + ldsw + _i * 8192), 16, 0, 0); } while (0)
#define PG8_LDA(dst, b, h) do { _Pragma("unroll") for (int m = 0; m < 4; ++m) _Pragma("unroll") for (int k = 0; k < 2; ++k) dst[m][k] = *(const PG8_LAS bf16x8*)(lds + PG8_SA(b, h) + aoff + m * 2048 + k * 1024); } while (0)
#define PG8_LDB(dst, b, h) do { _Pragma("unroll") for (int n = 0; n < 2; ++n) _Pragma("unroll") for (int k = 0; k < 2; ++k) dst[n][k] = *(const PG8_LAS bf16x8*)(lds + PG8_SB(b, h) + boff + n * 2048 + k * 1024); } while (0)
#define PG8_MMA(ai, bj, At, Bt) do { __builtin_amdgcn_s_setprio(1); _Pragma("unroll") for (int m = 0; m < 4; ++m) _Pragma("unroll") for (int n = 0; n < 2; ++n) _Pragma("unroll") for (int k = 0; k < 2; ++k) \
        acc[ai][bj][m][n] = __builtin_amdgcn_mfma_f32_16x16x32_bf16(Bt[n][k], At[m][k], acc[ai][bj][m][n], 0, 0, 0); __builtin_amdgcn_s_setprio(0); } while (0)
#define PG8_WAIT_V(n) asm volatile("s_waitcnt vmcnt(" #n ")" ::: "memory")
#define PG8_WAIT_L(n) asm volatile("s_waitcnt lgkmcnt(" #n ")" ::: "memory")
#define PG8_BAR __builtin_amdgcn_s_barrier()
#define PG8_SCHED __builtin_amdgcn_sched_barrier(0)
    Unit cur, nxt; int ui = 0;
    if (!S.next(0, cur)) return;
    f32x4 acc[2][2][4][2];
#pragma unroll
    for (int a = 0; a < 2; ++a)
#pragma unroll
        for (int b = 0; b < 2; ++b)
#pragma unroll
            for (int m = 0; m < 4; ++m)
#pragma unroll
                for (int n = 0; n < 2; ++n) acc[a][b][m][n] = (f32x4){0.f, 0.f, 0.f, 0.f};
    bf16x8 At[4][2], B0[2][2], B1[2][2];
    const char* cA = (const char*)g.A + (size_t)cur.pm * tstep; const char* cB = (const char*)g.Bt + (size_t)cur.pn * tstep;
    S.a_ready(cur);
    if constexpr (SP2) {
        PG8_STAGE(PG8_SB(0, 0), cB, voffB); PG8_STAGE(PG8_SB(0, 1), cB + hstep, voffB); PG8_STAGE(PG8_SA(0, 0), cA, voffA); PG8_STAGE(PG8_SA(0, 1), cA + hstep, voffA);
        if (wr == 1) PG8_BAR;
        PG8_WAIT_V(2); PG8_BAR;
        PG8_STAGE(PG8_SB(1, 0), cB + kstep, voffB); PG8_STAGE(PG8_SA(1, 0), cA + kstep, voffA); PG8_STAGE(PG8_SB(1, 1), cB + hstep + kstep, voffB);
        PG8_WAIT_V(6); PG8_BAR;
    } else {
        PG8_STAGE(PG8_SB(0, 0), cB, voffB); PG8_STAGE(PG8_SA(0, 0), cA, voffA); PG8_STAGE(PG8_SB(0, 1), cB + hstep, voffB); PG8_STAGE(PG8_SA(0, 1), cA + hstep, voffA);
        if (wr == 1) PG8_BAR;
        PG8_WAIT_V(4); PG8_BAR;
        PG8_STAGE(PG8_SB(1, 0), cB + kstep, voffB); PG8_STAGE(PG8_SA(1, 0), cA + kstep, voffA); PG8_STAGE(PG8_SB(1, 1), cB + hstep + kstep, voffB);
        PG8_WAIT_V(6); PG8_BAR;
    }
    for (;;) {
        const bool has_next = S.next(ui + 1, nxt);
        const char* nA = has_next ? (const char*)g.A + (size_t)nxt.pm * tstep : cA; const char* nB = has_next ? (const char*)g.Bt + (size_t)nxt.pn * tstep : cB;
        for (int t = 0; t < nt; t += 2) {
            const bool last = (t == nt - 2);
            const char* a1 = cA + (size_t)(t + 1) * kstep;
            const char* a2 = last ? nA : cA + (size_t)(t + 2) * kstep; const char* b2 = last ? nB : cB + (size_t)(t + 2) * kstep;
            const char* a3 = a2 + kstep; const char* b3 = b2 + kstep;
            if (last && has_next) S.a_ready(nxt);
            if constexpr (SP2) {
            PG8_LDB(B0, 0, 0); PG8_LDB(B1, 0, 1); PG8_SCHED; PG8_LDA(At, 0, 0); PG8_STAGE(PG8_SA(1, 1), a1 + hstep, voffA);
            PG8_WAIT_V(8); PG8_WAIT_L(0); PG8_BAR; PG8_MMA(0, 0, At, B0); PG8_MMA(0, 1, At, B1); PG8_BAR; PG8_SCHED;
            PG8_LDA(At, 0, 1); PG8_STAGE(PG8_SB(0, 0), b2, voffB); PG8_STAGE(PG8_SB(0, 1), b2 + hstep, voffB); PG8_STAGE(PG8_SA(0, 0), a2, voffA);
            PG8_WAIT_V(8); PG8_WAIT_L(0); PG8_BAR; PG8_MMA(1, 0, At, B0); PG8_MMA(1, 1, At, B1); PG8_BAR; PG8_SCHED;
            PG8_LDB(B0, 1, 0); PG8_LDB(B1, 1, 1); PG8_SCHED; PG8_LDA(At, 1, 0); PG8_STAGE(PG8_SA(0, 1), a2 + hstep, voffA);
            PG8_WAIT_V(8); PG8_WAIT_L(0); PG8_BAR; PG8_MMA(0, 0, At, B0); PG8_MMA(0, 1, At, B1); PG8_BAR; PG8_SCHED;
            PG8_LDA(At, 1, 1); PG8_STAGE(PG8_SB(1, 0), b3, voffB); PG8_STAGE(PG8_SB(1, 1), b3 + hstep, voffB); PG8_STAGE(PG8_SA(1, 0), a3, voffA);
            PG8_WAIT_V(8); PG8_WAIT_L(0); PG8_BAR; PG8_MMA(1, 0, At, B0); PG8_MMA(1, 1, At, B1); PG8_BAR; PG8_SCHED;
            } else {
            PG8_LDB(B0, 0, 0); PG8_SCHED; PG8_LDA(At, 0, 0); PG8_STAGE(PG8_SA(1, 1), a1 + hstep, voffA);
            PG8_WAIT_L(8); PG8_BAR; PG8_WAIT_L(0); PG8_MMA(0, 0, At, B0); PG8_BAR; PG8_SCHED;
            PG8_LDB(B1, 0, 1); PG8_STAGE(PG8_SB(0, 0), b2, voffB);
            PG8_BAR; PG8_WAIT_L(0); PG8_MMA(0, 1, At, B1); PG8_BAR;
            PG8_LDA(At, 0, 1); PG8_STAGE(PG8_SA(0, 0), a2, voffA);
            PG8_BAR; PG8_WAIT_L(0); PG8_MMA(1, 0, At, B0); PG8_BAR; PG8_SCHED;
            PG8_STAGE(PG8_SB(0, 1), b2 + hstep, voffB);
            PG8_WAIT_V(6); PG8_BAR; PG8_MMA(1, 1, At, B1); PG8_BAR;
            PG8_LDB(B0, 1, 0); PG8_SCHED; PG8_LDA(At, 1, 0); PG8_STAGE(PG8_SA(0, 1), a2 + hstep, voffA);
            PG8_WAIT_L(8); PG8_BAR; PG8_WAIT_L(0); PG8_MMA(0, 0, At, B0); PG8_BAR; PG8_SCHED;
            PG8_LDB(B1, 1, 1); PG8_STAGE(PG8_SB(1, 0), b3, voffB);
            PG8_BAR; PG8_WAIT_L(0); PG8_MMA(0, 1, At, B1); PG8_BAR;
            PG8_LDA(At, 1, 1); PG8_STAGE(PG8_SA(1, 0), a3, voffA);
            PG8_BAR; PG8_WAIT_L(0); PG8_MMA(1, 0, At, B0); PG8_BAR; PG8_SCHED;
            PG8_STAGE(PG8_SB(1, 1), b3 + hstep, voffB);
            PG8_WAIT_V(6); PG8_BAR; PG8_MMA(1, 1, At, B1); PG8_BAR;
            }
        }
        if constexpr (ALIGN_EPI) { if (wr == 0) PG8_BAR; }
        if constexpr (!Epi::AFTER_DRAIN) { E(acc, cur, wr, wc, fr, fq); S.done(cur); }
        if (!has_next) break;
#pragma unroll
        for (int a = 0; a < 2; ++a)
#pragma unroll
            for (int b = 0; b < 2; ++b)
#pragma unroll
                for (int m = 0; m < 4; ++m)
#pragma unroll
                    for (int n = 0; n < 2; ++n) acc[a][b][m][n] = (f32x4){0.f, 0.f, 0.f, 0.f};
        cur = nxt; cA = nA; cB = nB; ++ui;
        if constexpr (ALIGN_EPI) { if (wr == 1) PG8_BAR; }
    }
    PG8_WAIT_V(0);
    if constexpr (!ALIGN_EPI) { if (wr == 0) PG8_BAR; }
    PG8_BAR;
    if constexpr (Epi::AFTER_DRAIN) { E.fused(acc, cur, wr, wc, fr, fq, lds, wid, lane); S.done(cur); }
#undef PG8_SA
#undef PG8_SB
#undef PG8_STAGE
#undef PG8_LDA
#undef PG8_LDB
#undef PG8_MMA
#undef PG8_WAIT_V
#undef PG8_WAIT_L
#undef PG8_BAR
#undef PG8_SCHED
}
}
namespace pg8 {
typedef unsigned u32x2 __attribute__((ext_vector_type(2)));
__device__ __forceinline__ float sigmoidf_(float x) { return 1.0f / (1.0f + __expf(-x)); }
struct EpiBf {
    static constexpr bool PERM = true, AFTER_DRAIN = false;
    bf16_t* O; int ldc; int act;
    __device__ __forceinline__ void operator()(const f32x4 (&acc)[2][2][4][2], const Unit& u, int wr, int wc, int fr, int fq) const {
        const int row0 = u.pm * BM + wr * 64 + fr, col0 = u.pn * BM + wc * 32 + 8 * fq;
#pragma unroll
        for (int ai = 0; ai < 2; ++ai)
#pragma unroll
            for (int m = 0; m < 4; ++m) { bf16_t* rowp = O + (size_t)(row0 + ai * HALF + m * 16) * ldc + col0;
#pragma unroll
                for (int bj = 0; bj < 2; ++bj) { f32x4 v0 = acc[ai][bj][m][0], v1 = acc[ai][bj][m][1];
                    if (act == 1) {
#pragma unroll
                        for (int j = 0; j < 4; ++j) { v0[j] = sigmoidf_(v0[j]); v1[j] = sigmoidf_(v1[j]); } }
                    u32x4 w; w.x = cvt_pk_bf16(v0[0], v0[1]); w.y = cvt_pk_bf16(v0[2], v0[3]); w.z = cvt_pk_bf16(v1[0], v1[1]); w.w = cvt_pk_bf16(v1[2], v1[3]);
                    *(u32x4*)(rowp + bj * HALF) = w; } }
    }
};
struct EpiSwiglu {
    static constexpr bool PERM = true, AFTER_DRAIN = false;
    bf16_t* O; int ldc;
    __device__ __forceinline__ void operator()(const f32x4 (&acc)[2][2][4][2], const Unit& u, int wr, int wc, int fr, int fq) const {
        const int row0 = u.pm * BM + wr * 64 + fr, col0 = u.pn * HALF + wc * 32 + 8 * fq;
#pragma unroll
        for (int ai = 0; ai < 2; ++ai)
#pragma unroll
            for (int m = 0; m < 4; ++m) { bf16_t* rowp = O + (size_t)(row0 + ai * HALF + m * 16) * ldc + col0;
                f32x4 v0, v1;
#pragma unroll
                for (int j = 0; j < 4; ++j) { const float a0 = acc[ai][0][m][0][j], a1 = acc[ai][0][m][1][j];
                    v0[j] = a0 * sigmoidf_(a0) * acc[ai][1][m][0][j]; v1[j] = a1 * sigmoidf_(a1) * acc[ai][1][m][1][j]; }
                u32x4 w; w.x = cvt_pk_bf16(v0[0], v0[1]); w.y = cvt_pk_bf16(v0[2], v0[3]); w.z = cvt_pk_bf16(v1[0], v1[1]); w.w = cvt_pk_bf16(v1[2], v1[3]);
                *(u32x4*)rowp = w; }
    }
};
struct EpiF32 {
    static constexpr bool PERM = false, AFTER_DRAIN = false;
    float* C; int ldc;
    __device__ __forceinline__ void operator()(const f32x4 (&acc)[2][2][4][2], const Unit& u, int wr, int wc, int fr, int fq) const {
        const int row0 = u.pm * BM + wr * 64 + fr, col0 = u.pn * BM + wc * 32 + 4 * fq;
#pragma unroll
        for (int ai = 0; ai < 2; ++ai)
#pragma unroll
            for (int m = 0; m < 4; ++m) { float* rowp = C + (size_t)(row0 + ai * HALF + m * 16) * ldc + col0;
#pragma unroll
                for (int bj = 0; bj < 2; ++bj)
#pragma unroll
                    for (int n = 0; n < 2; ++n) *(f32x4*)(rowp + bj * HALF + n * 16) = acc[ai][bj][m][n]; }
    }
};
struct EpiUp {
    static constexpr bool PERM = false, AFTER_DRAIN = false;
    const bf16_t* gates; int ldg; int gcol0; float* T; bf16_t* GU; int mode;
    __device__ __forceinline__ void operator()(const f32x4 (&acc)[2][2][4][2], const Unit& u, int wr, int wc, int fr, int fq) const {
        const int row0 = u.pm * BM + wr * 64 + fr, col0 = u.pn * BM + wc * 32 + 4 * fq;
#pragma unroll
        for (int ai = 0; ai < 2; ++ai)
#pragma unroll
            for (int m = 0; m < 4; ++m) { const size_t row = (size_t)(row0 + ai * HALF + m * 16);
#pragma unroll
                for (int bj = 0; bj < 2; ++bj)
#pragma unroll
                    for (int n = 0; n < 2; ++n) { const int col = col0 + bj * HALF + n * 16;
                        const u32x2 g = *(const u32x2*)(gates + row * ldg + gcol0 + col);
                        f32x4 gv; gv[0] = __uint_as_float(g.x << 16); gv[1] = __uint_as_float(g.x & 0xffff0000u); gv[2] = __uint_as_float(g.y << 16); gv[3] = __uint_as_float(g.y & 0xffff0000u);
                        f32x4 v = acc[ai][bj][m][n] * gv; float* tp = T + row * 1024 + col;
                        if (mode == 0) { *(f32x4*)tp = v; }
                        else if (mode == 1) { *(f32x4*)tp = *(const f32x4*)tp + v; }
                        else { v = v + *(const f32x4*)tp; u32x2 w; w.x = cvt_pk_bf16(v[0], v[1]); w.y = cvt_pk_bf16(v[2], v[3]); *(u32x2*)(GU + row * 1024 + col) = w; } } }
    }
};
}
#define XB_TMO      128
#define XB_XCNT(j)  (256  + 64 * (j))
#define XB_XSUB(j)  (1280 + 64 * (j))
#define XB_XGEN(j)  (2304 + 64 * (j))
#define XB_TOP      3328
#define XB_TOPGEN   3392
#define XCD_BAR_WORDS 3456
#define XB_SPIN_CAP (1u << 18)

__device__ __forceinline__ unsigned xb_ld(unsigned* p)              { return __hip_atomic_load(p, __ATOMIC_RELAXED, __HIP_MEMORY_SCOPE_AGENT); }
__device__ __forceinline__ unsigned xb_add(unsigned* p, unsigned v) { return __hip_atomic_fetch_add(p, v, __ATOMIC_RELAXED, __HIP_MEMORY_SCOPE_AGENT); }
__device__ __forceinline__ unsigned xb_xcc_id() { return (unsigned)__builtin_amdgcn_s_getreg((3 << 11) | 20) & 0xFu; }
#define XB_SPIN(cond, bar) do { unsigned _sp = 0; while (cond) { __builtin_amdgcn_s_sleep(1); \
    if ((++_sp & 255u) == 0u) { if (xb_ld(&(bar)[XB_TMO])) break; if (_sp > XB_SPIN_CAP) { atomicAdd(&(bar)[XB_TMO], 1u); break; } } } } while (0)

struct XcdBarrier {
    unsigned* bar; unsigned x;
    volatile LAS unsigned* st;
};

__device__ __forceinline__ XcdBarrier xcd_barrier_post(unsigned* bar, volatile LAS unsigned* st) {
    XcdBarrier b; b.bar = bar; b.x = xb_xcc_id(); b.st = st;
    if (threadIdx.x == 0) (void)xb_add(&bar[XB_XCNT(b.x)], 1u);
    return b;
}
__device__ __forceinline__ void xcd_barrier_complete(unsigned* bar, unsigned x, unsigned& nloc, unsigned& nx) {
    const unsigned G = gridDim.x * gridDim.y * gridDim.z;
    unsigned sum, cnt, mine, sp = 0u;
    for (;;) {
        sum = 0u; cnt = 0u; mine = 0u;
#pragma unroll
        for (unsigned j = 0; j < 16; ++j) { const unsigned c = xb_ld(&bar[XB_XCNT(j)]); sum += c; cnt += (c > 0u) ? 1u : 0u; mine = (j == x) ? c : mine; }
        if (sum == G) break;
        __builtin_amdgcn_s_sleep(1);
        if ((++sp & 255u) == 0u) { if (xb_ld(&bar[XB_TMO])) break; if (sp > XB_SPIN_CAP) { atomicAdd(&bar[XB_TMO], 1u); break; } }
    }
    nloc = mine > 0u ? mine : 1u; nx = cnt > 0u ? cnt : 1u;
}

__device__ __forceinline__ void xcd_barrier(const XcdBarrier& b) {
    asm volatile("s_waitcnt vmcnt(0)" ::: "memory");
    __syncthreads();
    if (threadIdx.x == 0) {
        unsigned* bar = b.bar;
        __builtin_amdgcn_s_waitcnt(0);
        unsigned nloc = b.st[0], nx = b.st[1];
        if (nloc == 0u) { xcd_barrier_complete(bar, b.x, nloc, nx); b.st[0] = nloc; b.st[1] = nx; }
        const unsigned old = xb_add(&bar[XB_XSUB(b.x)], 1u);
        const unsigned gen = old / nloc;
        if (old + 1u == (gen + 1u) * nloc) {
            __builtin_amdgcn_fence(__ATOMIC_RELEASE, "agent");
            asm volatile("s_waitcnt vmcnt(0)" ::: "memory");
            const unsigned og = xb_add(&bar[XB_TOP], 1u);
            const unsigned tg = og / nx;
            if (og + 1u == (tg + 1u) * nx) xb_add(&bar[XB_TOPGEN], 1u);
            else XB_SPIN(xb_ld(&bar[XB_TOPGEN]) == tg, bar);
            __builtin_amdgcn_fence(__ATOMIC_ACQUIRE, "agent");
            xb_add(&bar[XB_XGEN(b.x)], 1u);
            asm volatile("s_waitcnt vmcnt(0)" ::: "memory");
        } else {
            XB_SPIN(xb_ld(&bar[XB_XGEN(b.x)]) == gen, bar);
            __builtin_amdgcn_fence(__ATOMIC_ACQUIRE, "agent");
            asm volatile("s_waitcnt vmcnt(0)" ::: "memory");
        }
    }
    __syncthreads();
}
constexpr int NWAVES = 8;
constexpr int M = 12288, MP = 8192, DM = 1024, FF = 2816, NL = 2, NGRP = 5, NMOD = 9 * 1024;
constexpr int NKEYS = 8192 + 4 * 1280;
constexpr float ALPHA = 1.41421356237f, LN_EPS = 1e-5f, RMS_EPS = 1e-6f, GN_EPS = 64e-5f;
constexpr float QSCALE = 0.125f * 1.4426950408889634f;
constexpr size_t MiB = 1u << 20;
constexpr size_t WS_CTL = 0, CTL_ZERO_BYTES = 1 * MiB;
constexpr size_t WS_MOD = 1 * MiB;
constexpr size_t WS_LAM = WS_MOD + 512 * 1024;
constexpr size_t WS_LORA = 2 * MiB;
constexpr size_t WS_PTRS = 2 * MiB + 896 * 1024;
constexpr size_t WS_BON = 3 * MiB;
constexpr size_t WS_XBUF = 3 * MiB + 512 * 1024;
constexpr size_t WS_WB = 4 * MiB;
constexpr size_t WS_H = 109 * MiB;
constexpr size_t WS_BIG = 133 * MiB;
constexpr size_t WS_END = 352 * MiB;
constexpr size_t WL_W1A = 0, WL_W1B = 5767168, WL_WIN = 8650752, WL_WUP = 16252928, WL_WO = 17825792, WL_W2A = 18874368, WL_W2B = 24641536, WL_SIZE = 27525120;
constexpr int WIN_ATT = 0, WIN_RWKV = 2304, WIN_GATE = 4352, WIN_ROWS = 7424;
constexpr size_t B_ACT = 0, B_Z2 = 66 * MiB;
constexpr size_t B_PQA = 0, B_PQR = 0;
constexpr size_t B_QA = 54 * MiB, B_QB = 66 * MiB, B_KA = 78 * MiB, B_VA = B_KA + 3328 * 1024, B_KB = B_VA + 3328 * 1024, B_VB = B_KB + 13 * MiB;
constexpr size_t B_SR = 111 * MiB, B_SK = 123 * MiB, B_SKK = 135 * MiB, B_SV = 147 * MiB, B_SA0 = 159 * MiB, B_SA1 = 171 * MiB, B_SW0 = 183 * MiB, B_SW1 = 195 * MiB, B_G = 207 * MiB;
constexpr size_t B_OA = 0, B_OB = 12 * MiB, B_OF = 24 * MiB, B_OBW = 36 * MiB, B_OC = 54 * MiB;
constexpr size_t B_GATES = 66 * MiB, B_T = 138 * MiB, B_GU = 186 * MiB, B_Z1 = 0;
static_assert(B_VB + 13 * MiB <= B_SR && B_G + 12 * MiB <= WS_END - WS_BIG && B_GU + 24 * MiB <= WS_END - WS_BIG, "BIG map");
constexpr size_t O_Y = 0, O_NAK = 12582912, O_NAV = 14680064, O_NDK = 16777216, O_NDV = 25165824, O_NST = 33554432, O_TOTAL = 37748736;
constexpr int RING_OFF = 0, RING_BYTES = 131072, LDSCTL_OFF = RING_BYTES, MISC_OFF = LDSCTL_OFF + 320, LDS_BYTES = 147456;
constexpr int CW_TMO = 0, CW_CODE = 1, CW_BAR = 4096, CW_SEAM = 16384;
struct Args { const float* in[32]; float* out; unsigned char* ws; int ph_lo, ph_hi, rep0, pad; };
struct Frame {
    LAS unsigned char* lds;
    int tid, lane, wave, G, bid, gw, NGW;
    const float* const* tbl; float* out; unsigned char* ws; unsigned char* big;
};
__device__ __forceinline__ float bflo(unsigned w) { return __uint_as_float(w << 16); }
__device__ __forceinline__ float bfhi(unsigned w) { return __uint_as_float(w & 0xffff0000u); }
__device__ __forceinline__ float bf1(bf16 v) { return __uint_as_float((unsigned)v << 16); }
__device__ __forceinline__ void unpack4(unsigned long long w, float (&o)[4]) { const unsigned lo = (unsigned)w, hi = (unsigned)(w >> 32); o[0] = bflo(lo); o[1] = bfhi(lo); o[2] = bflo(hi); o[3] = bfhi(hi); }
__device__ __forceinline__ float sigm(float x) { return 1.0f / (1.0f + __expf(-x)); }
__device__ __forceinline__ float wave_sum(float v) {
#pragma unroll
    for (int o = 1; o < 64; o <<= 1) v += __shfl_xor(v, o);
    return v;
}
__device__ __forceinline__ float wave_max(float v) {
#pragma unroll
    for (int o = 1; o < 64; o <<= 1) v = fmaxf(v, __shfl_xor(v, o));
    return v;
}
__device__ __forceinline__ float red16(float v) { v += __shfl_xor(v, 1); v += __shfl_xor(v, 2); v += __shfl_xor(v, 4); v += __shfl_xor(v, 8); return v; }
__device__ __forceinline__ int row_group(int m) { return m < MP ? 0 : 1 + ((m - MP) >> 10); }
__device__ __forceinline__ int key_base(int seq) { return seq < 32 ? seq * 256 : 8192 + (seq - 32) * 1280; }
__device__ __forceinline__ const float* modp(const Frame& F, int l, int g, int i) { return (const float*)(F.ws + WS_MOD) + ((size_t)(l * NGRP + g) * 9 + i) * 1024; }
__device__ __forceinline__ bf16* wlayer(const Frame& F, int l) { return (bf16*)(F.ws + WS_WB) + (size_t)l * WL_SIZE; }

__device__ __forceinline__ void p0_item(const float* Wsrc  , int ldw, int K, bf16* WTrow0  , int kb, bool zero, LAS float* scr, int lane) {
    const int k0 = 64 * kb;
    if (zero) {
#pragma unroll
        for (int j = 0; j < 4; ++j) { const int n = (lane >> 3) + 8 * j; *(GAS v4u*)(WTrow0 + (size_t)n * K + k0 + 8 * (lane & 7)) = (v4u){0u, 0u, 0u, 0u}; }
        return;
    }
    f32x4 rv[8];
#pragma unroll
    for (int i = 0; i < 8; ++i) rv[i] = *(const f32x4*)(Wsrc + (size_t)(k0 + 8 * i + (lane >> 3)) * ldw + 4 * (lane & 7));
#pragma unroll
    for (int i = 0; i < 8; ++i) { LAS float* d = scr + (8 * i + (lane >> 3)) * 33 + 4 * (lane & 7); d[0] = rv[i][0]; d[1] = rv[i][1]; d[2] = rv[i][2]; d[3] = rv[i][3]; }
    LDS_WAIT(); asm volatile("" ::: "memory");
    const int c = lane & 7;
#pragma unroll
    for (int j = 0; j < 4; ++j) { const int n = (lane >> 3) + 8 * j; const LAS float* s = scr + (8 * c) * 33 + n;
        v4u o; o.x = pk2(s[0 * 33], s[1 * 33]); o.y = pk2(s[2 * 33], s[3 * 33]); o.z = pk2(s[4 * 33], s[5 * 33]); o.w = pk2(s[6 * 33], s[7 * 33]);
        *(GAS v4u*)(WTrow0 + (size_t)n * K + k0 + 8 * c) = o; }
    LDS_WAIT(); asm volatile("" ::: "memory");
}
constexpr int IT_W1A = 16 * 176, IT_W1B = 44 * 32, IT_WIN = 16 * 232, IT_WUP = 3 * 8 * 32, IT_WO = 16 * 32, IT_LAYER = 2 * IT_W1A + 2 * IT_W1B + IT_WIN + IT_WUP + IT_WO;
__device__ __forceinline__ void conv_item(const Frame& F, int it, LAS float* scr) {
    const int l = it / IT_LAYER; int r = it % IT_LAYER; bf16* wl = wlayer(F, l); const int lane = F.lane;
    for (int f = 0; f < 2; ++f) {
        if (r < IT_W1A) { const int kb = r / 176, db = r % 176, tile = db >> 3, half = (db >> 2) & 1, q = db & 3;
            p0_item(F.tbl[13] + (size_t)(l * 2 + f) * 1024 * 5632 + half * 2816 + tile * 128 + q * 32, 5632, 1024, wl + (f ? WL_W2A : WL_W1A) + (size_t)(32 * db) * 1024, kb, false, scr, lane); return; }
        r -= IT_W1A;
        if (r < IT_W1B) { const int kb = r / 32, db = r % 32;
            p0_item(F.tbl[14] + (size_t)(l * 2 + f) * 2816 * 1024 + 32 * db, 1024, 2816, wl + (f ? WL_W2B : WL_W1B) + (size_t)(32 * db) * 2816, kb, false, scr, lane); return; }
        r -= IT_W1B;
    }
    if (r < IT_WIN) { const int kb = r / 232, db = r % 232, row = 32 * db; int src = 0; bool zero = false;
        if (row < WIN_RWKV) src = 3072 + row; else if (row < WIN_GATE) { const int rr = row - WIN_RWKV; if (rr < 1920) src = 5376 + rr; else zero = true; } else src = row - WIN_GATE;
        p0_item(F.tbl[15] + (size_t)l * 1024 * 7296 + src, 7296, 1024, wl + WL_WIN + (size_t)row * 1024, kb, zero, scr, lane); return; }
    r -= IT_WIN;
    if (r < IT_WUP) { const int i = r / 256, r2 = r % 256, kb = r2 / 32, db = r2 % 32;
        p0_item(F.tbl[30] + (size_t)(l * 3 + i) * 512 * 1024 + 32 * db, 1024, 512, wl + WL_WUP + (size_t)i * 524288 + (size_t)(32 * db) * 512, kb, false, scr, lane); return; }
    r -= IT_WUP;
    { const int kb = r / 32, db = r % 32;
      p0_item(F.tbl[31] + (size_t)l * 1024 * 1024 + 32 * db, 1024, 1024, wl + WL_WO + (size_t)(32 * db) * 1024, kb, false, scr, lane); }
}
__device__ __forceinline__ void phase_conv(const Frame& F) {
    LAS float* red = (LAS float*)(F.lds + RING_OFF);
    for (int task = F.bid; task < NL * (NMOD / 64); task += F.G) {
        const int l = task / (NMOD / 64), n = (task % (NMOD / 64)) * 64 + F.lane;
        const float* wm = F.tbl[9] + (size_t)l * 1024 * NMOD + n;
        float acc[NGRP] = {0.f, 0.f, 0.f, 0.f, 0.f};
        const int k0 = F.wave * 128;
#pragma unroll 4
        for (int k = k0; k < k0 + 128; ++k) {
            const float w = wm[(size_t)k * NMOD];
#pragma unroll
            for (int g = 0; g < NGRP; ++g) { const float cv = g == 0 ? F.tbl[8][k] : F.tbl[7][(g - 1) * 1024 + k]; acc[g] += cv * sigm(cv) * w; }
        }
#pragma unroll
        for (int g = 0; g < NGRP; ++g) red[(F.wave * NGRP + g) * 64 + F.lane] = acc[g];
        __syncthreads();
        if (F.wave < NGRP) { float s = F.tbl[10][(size_t)l * NMOD + n];
#pragma unroll
            for (int w = 0; w < 8; ++w) s += red[(w * NGRP + F.wave) * 64 + F.lane];
            ((float*)(F.ws + WS_MOD))[(size_t)(l * NGRP + F.wave) * NMOD + n] = s; }
        __syncthreads();
    }
    LAS float* scr = (LAS float*)(F.lds + RING_OFF + F.wave * 16384);
    for (int it = F.gw; it < NL * IT_LAYER; it += F.NGW) conv_item(F, it, scr);
    bf16* lora = (bf16*)(F.ws + WS_LORA);
    const int gt = F.gw * 64 + F.lane, NT = F.NGW * 64;
    for (int e = gt; e < NL * 196608; e += NT) {
        const int l = e / 196608, r = e % 196608; float v;
        if (r < 65536) { const int d = r >> 15, c = (r >> 6) & 511, rr = r & 63; v = F.tbl[21][((size_t)(l * 2 + d) * 64 + rr) * 512 + c]; }
        else if (r < 131072) { const int r2 = r - 65536, d = r2 >> 15, c = (r2 >> 6) & 511, rr = r2 & 63; v = F.tbl[23][((size_t)(l * 2 + d) * 64 + rr) * 512 + c]; }
        else { const int r2 = r - 131072, c = r2 >> 7, rr = r2 & 127; v = F.tbl[24][((size_t)l * 128 + rr) * 512 + c]; }
        lora[e] = (bf16)f2bf(v);
    }
    if (F.bid == 0 && F.wave == 0) {
        for (int l = 0; l < NL; ++l) { const float* lv = F.tbl[17] + l * 256;
            const float d01 = wave_sum(lv[F.lane] * lv[64 + F.lane]), d23 = wave_sum(lv[128 + F.lane] * lv[192 + F.lane]);
            if (F.lane == 0) ((float*)(F.ws + WS_LAM))[l] = __expf(d01) - __expf(d23) + (0.8f - 0.6f * __expf(-0.3f * (float)l)); }
    }
}
__device__ __forceinline__ void phase_init(const Frame& F) {
    for (int m = F.gw; m < M; m += F.NGW) {
        const float* xr = m < MP ? F.tbl[0] + (size_t)m * DM : F.tbl[1] + (size_t)(m - MP) * DM;
        const int g = row_group(m); const float* sh = modp(F, 0, g, 0); const float* sc = modp(F, 0, g, 1);
        float* X = F.out + (size_t)m * DM; bf16* H = (bf16*)(F.ws + WS_H) + (size_t)m * DM;
#pragma unroll
        for (int j = 0; j < 4; ++j) { const int c = 4 * F.lane + 256 * j; const f32x4 v = *(const f32x4*)(xr + c), s1 = *(const f32x4*)(sc + c), s0 = *(const f32x4*)(sh + c);
            *(f32x4*)(X + c) = v; const f32x4 h = v * (s1 + 1.0f) + s0;
            unsigned long long o = (unsigned long long)pk2(h[0], h[1]) | ((unsigned long long)pk2(h[2], h[3]) << 32); *(unsigned long long*)(H + c) = o; }
    }
}
__device__ __forceinline__ void phase_ln(const Frame& F, int l, int s, const float* Z) {
    const float gs = (s == 1) ? 1.0f : 0.5f; const int l2 = s < 2 ? l : l + 1, s2 = s < 2 ? s + 1 : 0;
    const float* lng = F.tbl[11] + (size_t)(l * 3 + s) * DM; const float* lnb = F.tbl[12] + (size_t)(l * 3 + s) * DM;
    for (int m = F.gw; m < M; m += F.NGW) {
        const int g = row_group(m); const float* gate = modp(F, l, g, 3 * s + 2);
        float* X = F.out + (size_t)m * DM; const float* zr = Z + (size_t)m * DM; bf16* H = (bf16*)(F.ws + WS_H) + (size_t)m * DM;
        f32x4 v[4]; float sum = 0.f;
#pragma unroll
        for (int j = 0; j < 4; ++j) { const int c = 4 * F.lane + 256 * j; const f32x4 x = *(const f32x4*)(X + c), z = *(const f32x4*)(zr + c), gt = *(const f32x4*)(gate + c);
            v[j] = x * ALPHA + gt * z * gs; sum += (v[j][0] + v[j][1]) + (v[j][2] + v[j][3]); }
        const float mean = wave_sum(sum) * (1.0f / DM); float s2q = 0.f;
#pragma unroll
        for (int j = 0; j < 4; ++j) { v[j] = v[j] - mean; s2q += (v[j][0] * v[j][0] + v[j][1] * v[j][1]) + (v[j][2] * v[j][2] + v[j][3] * v[j][3]); }
        const float rstd = 1.0f / sqrtf(wave_sum(s2q) * (1.0f / DM) + LN_EPS);
#pragma unroll
        for (int j = 0; j < 4; ++j) { const int c = 4 * F.lane + 256 * j; const f32x4 xn = v[j] * rstd * *(const f32x4*)(lng + c) + *(const f32x4*)(lnb + c);
            *(f32x4*)(X + c) = xn;
            if (l2 < NL) { const f32x4 s1 = *(const f32x4*)(modp(F, l2, g, 3 * s2 + 1) + c), s0 = *(const f32x4*)(modp(F, l2, g, 3 * s2) + c); const f32x4 h = xn * (s1 + 1.0f) + s0;
                unsigned long long o = (unsigned long long)pk2(h[0], h[1]) | ((unsigned long long)pk2(h[2], h[3]) << 32); *(unsigned long long*)(H + c) = o; } }
    }
}
namespace pg8 {
struct PanelStats {
    unsigned* xbuf;
    unsigned* cnt;
    unsigned* tmo;
    int ntn; float eps;
    unsigned code;
    __device__ __forceinline__ bool run(const f32x4 (&v)[2][2][4][2], const Unit& u, int wr, int wc, int fr, int fq, PG8_LAS unsigned char* lds, int wid, int lane) const {
        typedef float f32x2v __attribute__((ext_vector_type(2)));
        PG8_LAS f32x2v* P = (PG8_LAS f32x2v*)lds;
        PG8_LAS f32x2v* S = (PG8_LAS f32x2v*)(lds + 8192);
        PG8_LAS unsigned* flag = (PG8_LAS unsigned*)(lds + 8192 + 2048);
#pragma unroll
        for (int ai = 0; ai < 2; ++ai)
#pragma unroll
            for (int m = 0; m < 4; ++m) {
                float s = 0.f;
#pragma unroll
                for (int bj = 0; bj < 2; ++bj)
#pragma unroll
                    for (int n = 0; n < 2; ++n) { const f32x4 x = v[ai][bj][m][n]; s += (x[0] + x[1]) + (x[2] + x[3]); }
                s += __shfl_xor(s, 16); s += __shfl_xor(s, 32);
                const float mw = s * (1.0f / 64.0f); float q = 0.f;
#pragma unroll
                for (int bj = 0; bj < 2; ++bj)
#pragma unroll
                    for (int n = 0; n < 2; ++n) { const f32x4 d = v[ai][bj][m][n] - mw; q += (d[0] * d[0] + d[1] * d[1]) + (d[2] * d[2] + d[3] * d[3]); }
                q += __shfl_xor(q, 16); q += __shfl_xor(q, 32);
                if (fq == 0) P[(ai * HALF + wr * 64 + m * 16 + fr) * 4 + wc] = (f32x2v){mw, q};
            }
        asm volatile("s_waitcnt lgkmcnt(0)" ::: "memory"); __builtin_amdgcn_s_barrier(); asm volatile("" ::: "memory");
#if defined(BROKEN_EXCHANGE_NO_WAIT)
#warning BROKEN CONTROL BUILD: the row-statistics exchange does not wait; results are wrong by design
        if (blockIdx.x >= 64) { const long long t0_ = clock64(); while (clock64() - t0_ < 60000) __builtin_amdgcn_s_sleep(8); }
#endif
        const int row = wid * 32 + (lane & 31);
        if (lane < 32) {
            const f32x2v a = P[row * 4 + 0], b = P[row * 4 + 1], c = P[row * 4 + 2], d = P[row * 4 + 3];
            const float mt = (a.x + b.x + c.x + d.x) * 0.25f;
            const float da = a.x - mt, db = b.x - mt, dc = c.x - mt, dd = d.x - mt;
            const float m2 = (a.y + b.y) + (c.y + d.y) + 64.0f * ((da * da + db * db) + (dc * dc + dd * dd));
            unsigned long long* slot = (unsigned long long*)xbuf + ((size_t)(u.pm * BM + row) * 4 + u.pn);
            __hip_atomic_store(slot, ((unsigned long long)__float_as_uint(m2) << 32) | __float_as_uint(mt), __ATOMIC_RELAXED, __HIP_MEMORY_SCOPE_AGENT);
        }
        asm volatile("s_waitcnt vmcnt(0)" ::: "memory");
        if (lane == 0) __hip_atomic_fetch_add(cnt + 64 * u.pm, 1u, __ATOMIC_RELAXED, __HIP_MEMORY_SCOPE_AGENT);
        if (wid == 0) {
            bool dead = false; const unsigned long long t0 = __builtin_amdgcn_s_memrealtime(); const unsigned want = 8u * (unsigned)ntn;
            for (;;) {
#if defined(BROKEN_EXCHANGE_NO_WAIT)
                break;
#endif
                if ((unsigned)__builtin_amdgcn_readfirstlane(__hip_atomic_load(cnt + 64 * u.pm, __ATOMIC_RELAXED, __HIP_MEMORY_SCOPE_AGENT)) >= want) break;
                if (__builtin_amdgcn_s_memrealtime() - t0 > 2000000ull) {
                    if (lane == 0) { unsigned expect = 0u; __hip_atomic_compare_exchange_strong(tmo + 1, &expect, code | (unsigned)(u.pm & 0xff), __ATOMIC_RELAXED, __ATOMIC_RELAXED, __HIP_MEMORY_SCOPE_AGENT);
                                     __hip_atomic_store(tmo, 1u, __ATOMIC_RELAXED, __HIP_MEMORY_SCOPE_AGENT); }
                    dead = true; break; }
                __builtin_amdgcn_s_sleep(2);
            }
            __builtin_amdgcn_fence(__ATOMIC_ACQUIRE, "agent");
            if (lane == 0) flag[0] = dead ? 1u : 0u;
        }
        asm volatile("s_waitcnt vmcnt(0) lgkmcnt(0)" ::: "memory"); __builtin_amdgcn_s_barrier(); asm volatile("" ::: "memory");
        const bool bad = flag[0] != 0u;
        if (lane < 32) {
            const unsigned long long* slot = (const unsigned long long*)xbuf + (size_t)(u.pm * BM + row) * 4; float mt[4], m2[4]; float ms = 0.f;
#pragma unroll
            for (int t = 0; t < 4; ++t) { if (t < ntn) { const unsigned long long w = __hip_atomic_load(slot + t, __ATOMIC_RELAXED, __HIP_MEMORY_SCOPE_AGENT); mt[t] = __uint_as_float((unsigned)w); m2[t] = __uint_as_float((unsigned)(w >> 32)); } else { mt[t] = 0.f; m2[t] = 0.f; } ms += mt[t]; }
            const float mean = ms / (float)ntn; float q = 0.f;
#pragma unroll
            for (int t = 0; t < 4; ++t) if (t < ntn) { const float dm = mt[t] - mean; q += m2[t] + 256.0f * dm * dm; }
            S[row] = (f32x2v){mean, 1.0f / sqrtf(q / (256.0f * (float)ntn) + eps)};
        }
        asm volatile("s_waitcnt lgkmcnt(0)" ::: "memory"); __builtin_amdgcn_s_barrier(); asm volatile("" ::: "memory");
        return bad;
    }
};
struct EpiLn {
    static constexpr bool PERM = false, AFTER_DRAIN = true;
    unsigned char* ws; float* X; const float* const* tbl; int l, sub;
    __device__ __forceinline__ void fused(f32x4 (&acc)[2][2][4][2], const Unit& u, int wr, int wc, int fr_, int fq_, PG8_LAS unsigned char* lds, int wid, int lane) const {
        typedef float f32x2v __attribute__((ext_vector_type(2)));
        int fr = fr_, fq = fq_; asm volatile("" : "+v"(fr), "+v"(fq));
#define PG8_GAS __attribute__((address_space(1)))
        const PG8_LAS f32x2v* S = (const PG8_LAS f32x2v*)(lds + 8192);
        const int g = (u.pm * BM) < MP ? 0 : 1 + (((u.pm * BM) - MP) >> 10);
        const int col0 = u.pn * BM + wc * 32 + 4 * fq;
        const int l2 = sub < 2 ? l : l + 1, s2 = sub < 2 ? sub + 1 : 0, gi = 3 * sub + 2, si = 3 * s2 + 1, hi = 3 * s2; const bool modn = l2 < NL; const float gs = sub == 1 ? 1.0f : 0.5f;
        const float* mod = (const float*)(ws + WS_MOD); const float* modl = mod + (size_t)l * NGRP * NMOD; const float* modnx = mod + (size_t)(modn ? l2 : l) * NGRP * NMOD;
        PanelStats st{(unsigned*)(ws + WS_XBUF), (unsigned*)(ws + WS_CTL) + CW_SEAM + (l * 3 + sub) * 3072, (unsigned*)(ws + WS_CTL) + CW_TMO, 4, LN_EPS, 0x700u};
        PG8_GAS char* Xg = (PG8_GAS char*)X; PG8_GAS char* Hg = (PG8_GAS char*)(ws + WS_H);
        const PG8_GAS char* gateg = (const PG8_GAS char*)(modl + ((size_t)g * 9 + gi) * 1024); const PG8_GAS char* lngg = (const PG8_GAS char*)(tbl[11] + (size_t)(l * 3 + sub) * 1024); const PG8_GAS char* lnbg = (const PG8_GAS char*)(tbl[12] + (size_t)(l * 3 + sub) * 1024);
        const PG8_GAS char* scg = (const PG8_GAS char*)(modnx + ((size_t)g * 9 + si) * 1024); const PG8_GAS char* shg = (const PG8_GAS char*)(modnx + ((size_t)g * 9 + hi) * 1024);
        const unsigned rowoff = (unsigned)(u.pm * BM + wr * 64 + fr) * 4096u + (unsigned)col0 * 4u;
#pragma unroll
        for (int bj = 0; bj < 2; ++bj)
#pragma unroll
            for (int n = 0; n < 2; ++n) { const unsigned co = (unsigned)(bj * HALF + n * 16) * 4u; const f32x4 gv = *(const PG8_GAS f32x4*)(gateg + (unsigned)col0 * 4u + co) * gs;
#pragma unroll
                for (int ai = 0; ai < 2; ++ai) { f32x4 xv[4];
#pragma unroll
                    for (int m = 0; m < 4; ++m) xv[m] = *(const PG8_GAS f32x4*)(Xg + rowoff + (unsigned)(ai * HALF + m * 16) * 4096u + co);
#pragma unroll
                    for (int m = 0; m < 4; ++m) acc[ai][bj][m][n] = xv[m] * ALPHA + gv * acc[ai][bj][m][n];
                    asm volatile("" ::: "memory"); } }
        const bool bad = st.run(acc, u, wr, wc, fr, fq, lds, wid, lane);
        const float qnan = __builtin_nanf("");
#pragma unroll
        for (int bj = 0; bj < 2; ++bj)
#pragma unroll
            for (int n = 0; n < 2; ++n) { const unsigned co = (unsigned)(bj * HALF + n * 16) * 4u, cb = (unsigned)col0 * 4u + co;
                const f32x4 lg = *(const PG8_GAS f32x4*)(lngg + cb), lb = *(const PG8_GAS f32x4*)(lnbg + cb);
                f32x4 s1 = {0.f, 0.f, 0.f, 0.f}, s0 = s1; if (modn) { s1 = *(const PG8_GAS f32x4*)(scg + cb) + 1.0f; s0 = *(const PG8_GAS f32x4*)(shg + cb); }
#pragma unroll
                for (int ai = 0; ai < 2; ++ai)
#pragma unroll
                    for (int m = 0; m < 4; ++m) { const int r = ai * HALF + wr * 64 + m * 16 + fr; const f32x2v sr = S[r]; const unsigned off = rowoff + (unsigned)(ai * HALF + m * 16) * 4096u + co;
                        f32x4 xn = (acc[ai][bj][m][n] - sr.x) * sr.y * lg + lb; if (bad) xn = (f32x4){qnan, qnan, qnan, qnan};
                        *(PG8_GAS f32x4*)(Xg + off) = xn;
                        if (modn) { const f32x4 h = xn * s1 + s0; u32x2 w; w.x = cvt_pk_bf16(h[0], h[1]); w.y = cvt_pk_bf16(h[2], h[3]); *(PG8_GAS u32x2*)(Hg + (off >> 1)) = w; } }
                asm volatile("" ::: "memory"); }
    }
};
}
__device__ __forceinline__ float rope1(float x, int lane, int t) {
    const int i = lane & 15; const float pos = (float)((lane & 32) ? (t & 63) : (t >> 6));
    const float ang = pos * exp2f(-(float)i * 0.8304820237f);
    const float cs = cosf(ang), sn = sinf(ang); const float p = __shfl_xor(x, 16);
    return (lane & 16) ? (x * cs + p * sn) : (x * cs - p * sn);
}
__device__ __forceinline__ void phase_attprep(const Frame& F, int l) {
    const bf16* PQA = (const bf16*)(F.big + B_PQA);
    bf16* QA = (bf16*)(F.big + B_QA); bf16* QB = (bf16*)(F.big + B_QB); bf16* KA = (bf16*)(F.big + B_KA); bf16* VA = (bf16*)(F.big + B_VA); bf16* KB = (bf16*)(F.big + B_KB); bf16* VB = (bf16*)(F.big + B_VB);
    const int lane = F.lane; const float g0 = F.tbl[16][(l * 2 + 0) * 64 + lane], g1 = F.tbl[16][(l * 2 + 1) * 64 + lane];
    for (int m = F.gw; m < M; m += F.NGW) {
        const bool smp = m >= MP; const int seq = smp ? 32 + ((m - MP) >> 10) : (m >> 8), t = smp ? ((m - MP) & 1023) : (m & 255);
        const size_t key = (size_t)key_base(seq) + t; const bf16* pr = PQA + (size_t)m * 2304;
#pragma unroll
        for (int h = 0; h < 8; ++h) { const float x = bf1(pr[h * 64 + lane]); float xn = x * rsqrtf(wave_sum(x * x) * (1.0f / 64.0f) + RMS_EPS) * g0; if (smp) xn = rope1(xn, lane, t);
            QA[(size_t)m * 512 + h * 64 + lane] = (bf16)f2bf(xn * QSCALE); }
#pragma unroll
        for (int h = 0; h < 2; ++h) { const float x = bf1(pr[512 + h * 64 + lane]); float xn = x * rsqrtf(wave_sum(x * x) * (1.0f / 64.0f) + RMS_EPS) * g1; const float v = bf1(pr[640 + h * 64 + lane]);
            if (!smp) { const size_t o = ((size_t)((seq * 2 + l) * 2 + h) * 256 + t) * 64 + lane; F.out[O_NAK + o] = xn; F.out[O_NAV + o] = v; } else xn = rope1(xn, lane, t);
            KA[((size_t)h * NKEYS + key) * 64 + lane] = (bf16)f2bf(xn); VA[((size_t)h * NKEYS + key) * 64 + lane] = (bf16)f2bf(v); }
#pragma unroll
        for (int hc = 0; hc < 8; ++hc) { const int h = hc >> 1, c = hc & 1;
            float q = bf1(pr[768 + hc * 64 + lane]); float k = bf1(pr[1280 + hc * 64 + lane]); const float v = bf1(pr[1792 + hc * 64 + lane]);
            if (!smp) { const size_t o = ((size_t)((seq * 2 + l) * 4 + h) * 256 + t) * 128 + c * 64 + lane; F.out[O_NDK + o] = k; F.out[O_NDV + o] = v; } else { q = rope1(q, lane, t); k = rope1(k, lane, t); }
            QB[(size_t)m * 512 + hc * 64 + lane] = (bf16)f2bf(q * QSCALE);
            KB[((size_t)(h * 2 + c) * NKEYS + key) * 64 + lane] = (bf16)f2bf(k);
            VB[((size_t)h * NKEYS + key) * 128 + c * 64 + lane] = (bf16)f2bf(v); }
    }
    for (int it = F.gw; it < 4 * 256; it += F.NGW) { const int b = it >> 8, p = it & 255; const size_t key = (size_t)key_base(32 + b) + 1024 + p;
#pragma unroll
        for (int h = 0; h < 2; ++h) { const size_t s = ((size_t)((b * 2 + l) * 2 + h) * 256 + p) * 64 + lane;
            KA[((size_t)h * NKEYS + key) * 64 + lane] = (bf16)f2bf(F.tbl[2][s]); VA[((size_t)h * NKEYS + key) * 64 + lane] = (bf16)f2bf(F.tbl[3][s]); }
#pragma unroll
        for (int hc = 0; hc < 8; ++hc) { const int h = hc >> 1, c = hc & 1; const size_t s = ((size_t)((b * 2 + l) * 4 + h) * 256 + p) * 128 + c * 64 + lane;
            KB[((size_t)(h * 2 + c) * NKEYS + key) * 64 + lane] = (bf16)f2bf(F.tbl[4][s]); VB[((size_t)h * NKEYS + key) * 128 + c * 64 + lane] = (bf16)f2bf(F.tbl[5][s]); }
    }
}
struct RwkvBufs { bf16 *SR, *SK, *SKK, *SV, *SA0, *SA1, *G; _Float16 *SW0, *SW1; float* BON; };
__device__ __forceinline__ RwkvBufs rwkv_bufs(const Frame& F) {
    RwkvBufs b; b.SR = (bf16*)(F.big + B_SR); b.SK = (bf16*)(F.big + B_SK); b.SKK = (bf16*)(F.big + B_SKK); b.SV = (bf16*)(F.big + B_SV); b.SA0 = (bf16*)(F.big + B_SA0); b.SA1 = (bf16*)(F.big + B_SA1);
    b.G = (bf16*)(F.big + B_G); b.SW0 = (_Float16*)(F.big + B_SW0); b.SW1 = (_Float16*)(F.big + B_SW1); b.BON = (float*)(F.ws + WS_BON); return b;
}
__device__ __forceinline__ void mixed8(const bf16* PQR, const float* mu, int m, int cb, bool hp, bool hn, float (&o)[8]) {
    const v4u cur = *(const v4u*)(PQR + (size_t)m * 2048 + cb); v4u pv = {0u, 0u, 0u, 0u}, nv = {0u, 0u, 0u, 0u};
    if (hp) pv = *(const v4u*)(PQR + (size_t)(m - 1) * 2048 + cb);
    if (hn) nv = *(const v4u*)(PQR + (size_t)(m + 1) * 2048 + cb);
    const f32x4 m0 = *(const f32x4*)(mu + cb), m1 = *(const f32x4*)(mu + cb + 4);
#pragma unroll
    for (int w = 0; w < 4; ++w) { const float c0 = bflo(cur[w]), c1 = bfhi(cur[w]); const float mua = w < 2 ? m0[2 * w] : m1[2 * w - 4], mub = w < 2 ? m0[2 * w + 1] : m1[2 * w - 3];
        o[2 * w] = c0 + mua * (0.5f * (bflo(pv[w]) + bflo(nv[w])) - c0); o[2 * w + 1] = c1 + mub * (0.5f * (bfhi(pv[w]) + bfhi(nv[w])) - c1); }
}
__device__ __forceinline__ float mixed1(const bf16* PQR, float mu, int m, int c, bool hp, bool hn) {
    const float cur = bf1(PQR[(size_t)m * 2048 + c]); const float p = hp ? bf1(PQR[(size_t)(m - 1) * 2048 + c]) : 0.f, n = hn ? bf1(PQR[(size_t)(m + 1) * 2048 + c]) : 0.f;
    return cur + mu * (0.5f * (p + n) - cur);
}
__device__ __forceinline__ bf16x8 pack8(const float (&v)[8]) {
    v4u w; w.x = pk2(v[0], v[1]); w.y = pk2(v[2], v[3]); w.z = pk2(v[4], v[5]); w.w = pk2(v[6], v[7]); return __builtin_bit_cast(bf16x8, w);
}
__device__ __forceinline__ void mixed4(const bf16* PQR, const float* mu, int m, int c0, bool hp, bool hn, float (&o)[4]) {
    const unsigned long long cur = *(const unsigned long long*)(PQR + (size_t)m * 2048 + c0); unsigned long long pv = 0ull, nv = 0ull;
    if (hp) pv = *(const unsigned long long*)(PQR + (size_t)(m - 1) * 2048 + c0);
    if (hn) nv = *(const unsigned long long*)(PQR + (size_t)(m + 1) * 2048 + c0);
    const f32x4 mv = *(const f32x4*)(mu + c0); float c[4], p[4], n[4]; unpack4(cur, c); unpack4(pv, p); unpack4(nv, n);
#pragma unroll
    for (int j = 0; j < 4; ++j) o[j] = c[j] + mv[j] * (0.5f * (p[j] + n[j]) - c[j]);
}
__device__ __forceinline__ unsigned long long pack4(const float (&v)[4]) { return (unsigned long long)pk2(v[0], v[1]) | ((unsigned long long)pk2(v[2], v[3]) << 32); }
__device__ __forceinline__ void phase_rwkvprep(const Frame& F, int l) {
    const bf16* PQR = (const bf16*)(F.big + B_PQR); const RwkvBufs B = rwkv_bufs(F);
    const float* mu = F.tbl[19] + (size_t)l * 1920; const bf16* lora = (const bf16*)(F.ws + WS_LORA) + (size_t)l * 196608;
    const bf16* W2T = lora; const bf16* A2T = lora + 65536; const bf16* G2T = lora + 131072;
    const float* w0 = F.tbl[20] + (size_t)l * 1024; const float* a0p = F.tbl[22] + (size_t)l * 1024;
    const float* kkp = F.tbl[25] + (size_t)l * 512; const float* kap = F.tbl[26] + (size_t)l * 512; const float* rkp = F.tbl[27] + (size_t)l * 512;
    const int lane = F.lane, col = lane & 15, q = lane >> 4;
    for (int task = F.gw; task < (M / 16) * 8; task += F.NGW) {
        const int tok0 = (task >> 3) * 16, h = task & 7, m = tok0 + col;
        const bool smp = m >= MP; const int t = smp ? ((m - MP) & 1023) : (m & 255), T = smp ? 1024 : 256; const bool hp = t > 0, hn = t < T - 1;
        const int wrow = 64 * h + 16 * (col >> 2) + (col & 3);
        float ss = 0.f, bs = 0.f;
        { bf16x8 Bw[2][2], Ba[2][2]; float v[8];
#pragma unroll
          for (int d = 0; d < 2; ++d)
#pragma unroll
              for (int s = 0; s < 2; ++s) {
                  mixed8(PQR, mu, m, 1536 + d * 64 + 32 * s + 8 * q, hp, hn, v);
#pragma unroll
                  for (int j = 0; j < 8; ++j) v[j] = 1.0f - 2.0f / (1.0f + __expf(2.0f * v[j]));
                  Bw[d][s] = pack8(v);
                  mixed8(PQR, mu, m, 1664 + d * 64 + 32 * s + 8 * q, hp, hn, v); Ba[d][s] = pack8(v); }
#pragma unroll 1
          for (int cbi = 0; cbi < 4; ++cbi) {
              const int wr = wrow + 4 * cbi, c0 = 64 * h + 16 * q + 4 * cbi;
              f32x4 accw[2], acca[2];
#pragma unroll
              for (int d = 0; d < 2; ++d) { accw[d] = (f32x4){0.f, 0.f, 0.f, 0.f}; acca[d] = (f32x4){0.f, 0.f, 0.f, 0.f};
#pragma unroll
                  for (int s = 0; s < 2; ++s) {
                      const bf16x8 aw = *(const bf16x8*)(W2T + ((size_t)d * 512 + wr) * 64 + 32 * s + 8 * q), aa = *(const bf16x8*)(A2T + ((size_t)d * 512 + wr) * 64 + 32 * s + 8 * q);
                      accw[d] = __builtin_amdgcn_mfma_f32_16x16x32_bf16(aw, Bw[d][s], accw[d], 0, 0, 0);
                      acca[d] = __builtin_amdgcn_mfma_f32_16x16x32_bf16(aa, Ba[d][s], acca[d], 0, 0, 0); } }
              float r[4], k[4], v1[4]; mixed4(PQR, mu, m, c0, hp, hn, r); mixed4(PQR, mu, m, 512 + c0, hp, hn, k); mixed4(PQR, mu, m, 1024 + c0, hp, hn, v1);
              const f32x4 w00 = *(const f32x4*)(w0 + c0), w01 = *(const f32x4*)(w0 + 512 + c0), a00 = *(const f32x4*)(a0p + c0), a01 = *(const f32x4*)(a0p + 512 + c0);
              const f32x4 kkc = *(const f32x4*)(kkp + c0), kac = *(const f32x4*)(kap + c0), rkc = *(const f32x4*)(rkp + c0);
              float av0[4], av1[4], kr[4]; typedef _Float16 h4 __attribute__((ext_vector_type(4))); h4 d0, d1;
#pragma unroll
              for (int j = 0; j < 4; ++j) {
                  d0[j] = (_Float16)__expf(-0.6065306597f * sigm(w00[j] + accw[0][j])); d1[j] = (_Float16)__expf(-0.6065306597f * sigm(w01[j] + accw[1][j]));
                  av0[j] = sigm(a00[j] + acca[0][j]); av1[j] = sigm(a01[j] + acca[1][j]);
                  kr[j] = bf1((bf16)f2bf(k[j] * kkc[j])); ss += kr[j] * kr[j];
                  const float kh0 = k[j] * (1.0f + (av0[j] - 1.0f) * kac[j]), kh1 = k[j] * (1.0f + (av1[j] - 1.0f) * kac[j]); bs += r[j] * (kh0 + kh1) * rkc[j]; }
              const size_t o = (size_t)m * 512 + c0;
              *(unsigned long long*)(B.SR + o) = pack4(r); *(unsigned long long*)(B.SK + o) = pack4(k); *(unsigned long long*)(B.SV + o) = pack4(v1); *(unsigned long long*)(B.SKK + o) = pack4(kr);
              *(unsigned long long*)(B.SA0 + o) = pack4(av0); *(unsigned long long*)(B.SA1 + o) = pack4(av1); *(h4*)(B.SW0 + o) = d0; *(h4*)(B.SW1 + o) = d1;
          } }
        ss += __shfl_xor(ss, 16); ss += __shfl_xor(ss, 32); bs += __shfl_xor(bs, 16); bs += __shfl_xor(bs, 32);
        const float rn = rsqrtf(ss + 1e-12f);
#pragma unroll
        for (int cbi = 0; cbi < 4; ++cbi) { unsigned long long* pk = (unsigned long long*)(B.SKK + (size_t)m * 512 + 64 * h + 16 * q + 4 * cbi); float kr[4]; unpack4(*pk, kr);
#pragma unroll
            for (int j = 0; j < 4; ++j) kr[j] *= rn;
            *pk = pack4(kr); }
        if (q == 0) B.BON[(size_t)m * 8 + h] = bs;
        {
          bf16x8 Bg[4]; float v[8];
#pragma unroll
          for (int s = 0; s < 4; ++s) { mixed8(PQR, mu, m, 1792 + 32 * s + 8 * q, hp, hn, v);
#pragma unroll
              for (int j = 0; j < 8; ++j) v[j] = sigm(v[j]);
              Bg[s] = pack8(v); }
#pragma unroll
          for (int cbi = 0; cbi < 4; ++cbi) { const int wr = wrow + 4 * cbi, c0 = 64 * h + 16 * q + 4 * cbi; f32x4 accg = {0.f, 0.f, 0.f, 0.f};
#pragma unroll
              for (int s = 0; s < 4; ++s) { const bf16x8 ag = *(const bf16x8*)(G2T + (size_t)wr * 128 + 32 * s + 8 * q); accg = __builtin_amdgcn_mfma_f32_16x16x32_bf16(ag, Bg[s], accg, 0, 0, 0); }
              const float g4[4] = {accg[0], accg[1], accg[2], accg[3]}; *(unsigned long long*)(B.G + (size_t)m * 512 + c0) = pack4(g4); } }
    }
}
template <int DV> __device__ __forceinline__ void attn_row(const bf16* q, const bf16* K, const bf16* V, int nk, int lane, float (&O)[DV / 64], float& lsum) {
    float qf[64];
#pragma unroll
    for (int i = 0; i < 8; ++i) { const v4u w = *(const v4u*)(q + 8 * i);
#pragma unroll
        for (int j = 0; j < 4; ++j) { qf[8 * i + 2 * j] = bflo(w[j]); qf[8 * i + 2 * j + 1] = bfhi(w[j]); } }
    float mrun = -INFINITY; lsum = 0.f;
#pragma unroll
    for (int j = 0; j < DV / 64; ++j) O[j] = 0.f;
    for (int kt = 0; kt < nk; kt += 64) {
        const bf16* kr = K + (size_t)(kt + lane) * 64; float s = 0.f;
#pragma unroll
        for (int i = 0; i < 8; ++i) { const v4u w = *(const v4u*)(kr + 8 * i);
#pragma unroll
            for (int j = 0; j < 4; ++j) { s += qf[8 * i + 2 * j] * bflo(w[j]); s += qf[8 * i + 2 * j + 1] * bfhi(w[j]); } }
        const float mnew = fmaxf(mrun, wave_max(s)); const float p = exp2f(s - mnew), corr = exp2f(mrun - mnew);
        lsum = lsum * corr + wave_sum(p); mrun = mnew;
#pragma unroll
        for (int j = 0; j < DV / 64; ++j) O[j] *= corr;
        const bf16* vr = V + (size_t)kt * DV + lane;
#pragma unroll 16
        for (int kk = 0; kk < 64; ++kk) { const float pk = __shfl(p, kk);
#pragma unroll
            for (int j = 0; j < DV / 64; ++j) O[j] += pk * bf1(vr[(size_t)kk * DV + 64 * j]); }
    }
}
__device__ __forceinline__ void phase_attn_naive(const Frame& F, int l) {
    const bf16* QA = (const bf16*)(F.big + B_QA); const bf16* QB = (const bf16*)(F.big + B_QB); const bf16* KA = (const bf16*)(F.big + B_KA); const bf16* VA = (const bf16*)(F.big + B_VA);
    const bf16* KB = (const bf16*)(F.big + B_KB); const bf16* VB = (const bf16*)(F.big + B_VB); bf16* OA = (bf16*)(F.big + B_OA); bf16* OB = (bf16*)(F.big + B_OB);
    const float lam = ((const float*)(F.ws + WS_LAM))[l]; const float lam_init = 0.8f - 0.6f * __expf(-0.3f * (float)l);
    const int lane = F.lane;
    for (int task = F.gw; task < M * 12; task += F.NGW) {
        const int m = M - 1 - task / 12, item = task % 12;
        const bool smp = m >= MP; const int seq = smp ? 32 + ((m - MP) >> 10) : (m >> 8); const int nk = smp ? 1280 : 256; const size_t kb = key_base(seq);
        if (item < 8) { float O[1], ls; attn_row<64>(QA + (size_t)m * 512 + item * 64, KA + ((size_t)(item >> 2) * NKEYS + kb) * 64, VA + ((size_t)(item >> 2) * NKEYS + kb) * 64, nk, lane, O, ls);
            OA[(size_t)m * 512 + item * 64 + lane] = (bf16)f2bf(O[0] / ls); }
        else { const int h = item - 8; float O1[2], O2[2], l1, l2;
            attn_row<128>(QB + (size_t)m * 512 + h * 128, KB + ((size_t)(h * 2 + 0) * NKEYS + kb) * 64, VB + ((size_t)h * NKEYS + kb) * 128, nk, lane, O1, l1);
            attn_row<128>(QB + (size_t)m * 512 + h * 128 + 64, KB + ((size_t)(h * 2 + 1) * NKEYS + kb) * 64, VB + ((size_t)h * NKEYS + kb) * 128, nk, lane, O2, l2);
            const float o0 = O1[0] / l1 - lam * O2[0] / l2, o1 = O1[1] / l1 - lam * O2[1] / l2;
            const float rn = rsqrtf(wave_sum(o0 * o0 + o1 * o1) * (1.0f / 128.0f) + RMS_EPS) * (1.0f - lam_init);
            const float* sg = F.tbl[18] + (size_t)l * 128;
            OB[(size_t)m * 512 + h * 128 + lane] = (bf16)f2bf(o0 * rn * sg[lane]); OB[(size_t)m * 512 + h * 128 + 64 + lane] = (bf16)f2bf(o1 * rn * sg[64 + lane]); }
    }
}
__device__ __forceinline__ void phase_scan(const Frame& F, int l) {
    const RwkvBufs B = rwkv_bufs(F); bf16* OFW = (bf16*)(F.big + B_OF); bf16* OBW = (bf16*)(F.big + B_OBW);
    const int lane = F.lane, i = lane & 15, rl = lane >> 4;
    for (int task = F.gw; task < 1024 + 8192; task += F.NGW) {
        const bool smp = task < 1024; const int tt = smp ? task : task - 1024; const int sq = tt >> 8, h = (tt >> 5) & 7, dir = (tt >> 4) & 1, rg = tt & 15;
        const int T = smp ? 1024 : 256, m0 = smp ? MP + 1024 * sq : 256 * sq, row = 4 * rg + rl;
        float S[4] = {0.f, 0.f, 0.f, 0.f};
        if (smp) { const f32x4 s0 = *(const f32x4*)(F.tbl[6] + ((size_t)(((sq * 2 + l) * 2 + dir) * 8 + h) * 64 + row) * 64 + 4 * i); S[0] = s0[0]; S[1] = s0[1]; S[2] = s0[2]; S[3] = s0[3]; }
        const f32x4 ka4 = *(const f32x4*)(F.tbl[26] + (size_t)l * 512 + h * 64 + 4 * i);
        const bf16* SA = dir ? B.SA1 : B.SA0; const _Float16* SW = dir ? B.SW1 : B.SW0; bf16* OUT = dir ? OBW : OFW;
        for (int st = 0; st < T; ++st) {
            const int t = dir ? T - 1 - st : st; const size_t o = (size_t)(m0 + t) * 512 + h * 64;
            float r[4], k[4], kk[4], a[4], w[4];
            unpack4(*(const unsigned long long*)(B.SR + o + 4 * i), r); unpack4(*(const unsigned long long*)(B.SK + o + 4 * i), k); unpack4(*(const unsigned long long*)(B.SKK + o + 4 * i), kk);
            unpack4(*(const unsigned long long*)(SA + o + 4 * i), a);
            { typedef _Float16 h4 __attribute__((ext_vector_type(4))); const h4 wv = *(const h4*)(SW + o + 4 * i); w[0] = (float)wv[0]; w[1] = (float)wv[1]; w[2] = (float)wv[2]; w[3] = (float)wv[3]; }
            const float vv = bf1(B.SV[o + row]);
            float sa = 0.f;
#pragma unroll
            for (int c = 0; c < 4; ++c) sa -= S[c] * kk[c];
            sa = red16(sa);
            float ov = 0.f;
#pragma unroll
            for (int c = 0; c < 4; ++c) { const float kh = k[c] * (1.0f + (a[c] - 1.0f) * ka4[c]); S[c] = S[c] * w[c] + sa * (kk[c] * a[c]) + vv * kh; ov += S[c] * r[c]; }
            ov = red16(ov);
            if (i == 0) OUT[o + row] = (bf16)f2bf(ov);
        }
        if (!smp) *(f32x4*)(F.out + O_NST + ((size_t)(((sq * 2 + l) * 2 + dir) * 8 + h) * 64 + row) * 64 + 4 * i) = (f32x4){S[0], S[1], S[2], S[3]};
    }
}
__device__ __forceinline__ void phase_rwkvpost(const Frame& F, int l) {
    const RwkvBufs B = rwkv_bufs(F); const bf16* OFW = (const bf16*)(F.big + B_OF); const bf16* OBW = (const bf16*)(F.big + B_OBW); bf16* OC = (bf16*)(F.big + B_OC);
    const int lane = F.lane; const float* gng = F.tbl[28] + (size_t)l * 512 + 8 * lane; const float* gnb = F.tbl[29] + (size_t)l * 512 + 8 * lane;
    for (int m = F.gw; m < M; m += F.NGW) {
        const size_t o = (size_t)m * 512 + 8 * lane;
        const v4u a = *(const v4u*)(OFW + o), b = *(const v4u*)(OBW + o), vv = *(const v4u*)(B.SV + o), gg = *(const v4u*)(B.G + o);
        float x[8]; float s = 0.f;
#pragma unroll
        for (int j = 0; j < 4; ++j) { x[2 * j] = bflo(a[j]) + bflo(b[j]); x[2 * j + 1] = bfhi(a[j]) + bfhi(b[j]); s += x[2 * j] + x[2 * j + 1]; }
        s += __shfl_xor(s, 1); s += __shfl_xor(s, 2); s += __shfl_xor(s, 4); const float mean = s * (1.0f / 64.0f); float q = 0.f;
#pragma unroll
        for (int j = 0; j < 8; ++j) { x[j] -= mean; q += x[j] * x[j]; }
        q += __shfl_xor(q, 1); q += __shfl_xor(q, 2); q += __shfl_xor(q, 4); const float rstd = rsqrtf(q * (1.0f / 64.0f) + GN_EPS);
        const float bon = B.BON[(size_t)m * 8 + (lane >> 3)]; float y[8];
#pragma unroll
        for (int j = 0; j < 4; ++j) { const float v0 = bflo(vv[j]), v1 = bfhi(vv[j]), g0 = bflo(gg[j]), g1 = bfhi(gg[j]);
            y[2 * j] = (x[2 * j] * rstd * gng[2 * j] + gnb[2 * j] + bon * v0) * g0; y[2 * j + 1] = (x[2 * j + 1] * rstd * gng[2 * j + 1] + gnb[2 * j + 1] + bon * v1) * g1; }
        v4u w; w.x = pk2(y[0], y[1]); w.y = pk2(y[2], y[3]); w.z = pk2(y[4], y[5]); w.w = pk2(y[6], y[7]); *(v4u*)(OC + o) = w;
    }
}
typedef float f32x16 __attribute__((ext_vector_type(16)));
typedef short s16x4 __attribute__((ext_vector_type(4)));
typedef short v4i16_t __attribute__((ext_vector_type(4)));
constexpr int AT_KST = 144;
template <int DV> struct AttnLds { static constexpr int VST = DV * 2 + 16, KBYTES = 64 * AT_KST, VBYTES = 64 * VST, BUF = KBYTES + VBYTES; };
__device__ __forceinline__ float pl32_max(float m) { auto rr = __builtin_amdgcn_permlane32_swap(__float_as_uint(m), __float_as_uint(m), false, false); return fmaxf(__uint_as_float(rr[0]), __uint_as_float(rr[1])); }
__device__ __forceinline__ float pl32_sum(float m) { auto rr = __builtin_amdgcn_permlane32_swap(__float_as_uint(m), __float_as_uint(m), false, false); return __uint_as_float(rr[0]) + __uint_as_float(rr[1]); }
template <int DV> __device__ __forceinline__ void attn_stream(const Frame& F, const bf16x8 (&qf)[4], const bf16* K, const bf16* V, int nk, f32x16 (&o)[DV / 32], float& lsum_out) {
    typedef AttnLds<DV> L; constexpr int NV = DV / 64;
    const int tid = F.tid, lane = F.lane, r32 = lane & 31, hi = lane >> 5;
    LAS unsigned char* lds = F.lds;
    const int krow = tid >> 3, kch = tid & 7;
    const bf16* kg = K + (size_t)krow * 64 + kch * 8; const int klds = krow * AT_KST + kch * 16;
    int vlds[NV]; const bf16* vg[NV];
#pragma unroll
    for (int i = 0; i < NV; ++i) { const int idx = tid + 512 * i, row = idx / (DV / 8), ch = idx % (DV / 8); vg[i] = V + (size_t)row * DV + ch * 8; vlds[i] = L::KBYTES + row * L::VST + ch * 16; }
    const int kfo = r32 * AT_KST + hi * 16;
    const int vfo = L::KBYTES + (4 * hi + ((lane & 15) >> 2)) * L::VST + (((lane >> 4) & 1) * 16 + (lane & 3) * 4) * 2;
#pragma unroll
    for (int d = 0; d < DV / 32; ++d) o[d] = (f32x16){0.f, 0.f, 0.f, 0.f, 0.f, 0.f, 0.f, 0.f, 0.f, 0.f, 0.f, 0.f, 0.f, 0.f, 0.f, 0.f};
    float mrun = -INFINITY, lsum = 0.f;
    const int nt = nk >> 6;
    v4u kreg, vreg[NV];
    kreg = *(const v4u*)kg;
#pragma unroll
    for (int i = 0; i < NV; ++i) vreg[i] = *(const v4u*)vg[i];
    *(LAS v4u*)(lds + klds) = kreg;
#pragma unroll
    for (int i = 0; i < NV; ++i) *(LAS v4u*)(lds + vlds[i]) = vreg[i];
    __syncthreads();
    for (int t = 0; t < nt; ++t) {
        const int bo = (t & 1) * L::BUF, bn = ((t + 1) & 1) * L::BUF;
        if (t + 1 < nt) { kreg = *(const v4u*)(kg + (size_t)(t + 1) * 64 * 64);
#pragma unroll
            for (int i = 0; i < NV; ++i) vreg[i] = *(const v4u*)(vg[i] + (size_t)(t + 1) * 64 * DV); }
        f32x16 p0 = (f32x16){0.f, 0.f, 0.f, 0.f, 0.f, 0.f, 0.f, 0.f, 0.f, 0.f, 0.f, 0.f, 0.f, 0.f, 0.f, 0.f}, p1 = p0;
#pragma unroll
        for (int s = 0; s < 4; ++s) {
            const bf16x8 k0 = *(const LAS bf16x8*)(lds + bo + kfo + s * 32), k1 = *(const LAS bf16x8*)(lds + bo + kfo + 32 * AT_KST + s * 32);
            p0 = __builtin_amdgcn_mfma_f32_32x32x16_bf16(k0, qf[s], p0, 0, 0, 0); p1 = __builtin_amdgcn_mfma_f32_32x32x16_bf16(k1, qf[s], p1, 0, 0, 0); }
        float mx = fmaxf(p0[0], p1[0]);
#pragma unroll
        for (int r = 1; r < 16; ++r) mx = fmaxf(mx, fmaxf(p0[r], p1[r]));
        mx = pl32_max(mx);
        const float mnew = fmaxf(mrun, mx), corr = __builtin_amdgcn_exp2f(mrun - mnew); mrun = mnew;
        float ps = 0.f;
#pragma unroll
        for (int r = 0; r < 16; ++r) { p0[r] = __builtin_amdgcn_exp2f(p0[r] - mnew); p1[r] = __builtin_amdgcn_exp2f(p1[r] - mnew); ps += p0[r] + p1[r]; }
        lsum = lsum * corr + ps;
#pragma unroll
        for (int d = 0; d < DV / 32; ++d) o[d] *= corr;
#pragma unroll
        for (int hf = 0; hf < 2; ++hf)
#pragma unroll
            for (int s2 = 0; s2 < 2; ++s2) {
                v4u w; const f32x16& ph = hf ? p1 : p0;
                w.x = pg8::cvt_pk_bf16(ph[8 * s2 + 0], ph[8 * s2 + 1]); w.y = pg8::cvt_pk_bf16(ph[8 * s2 + 2], ph[8 * s2 + 3]); w.z = pg8::cvt_pk_bf16(ph[8 * s2 + 4], ph[8 * s2 + 5]); w.w = pg8::cvt_pk_bf16(ph[8 * s2 + 6], ph[8 * s2 + 7]);
                const bf16x8 pb = __builtin_bit_cast(bf16x8, w);
#pragma unroll
                for (int d = 0; d < DV / 32; ++d) {
                    const int off = bo + vfo + (32 * hf + 16 * s2) * L::VST + d * 64;
                    const s16x4 lo = __builtin_bit_cast(s16x4, __builtin_amdgcn_ds_read_tr16_b64_v4i16((LAS v4i16_t*)(lds + off)));
                    const s16x4 hh = __builtin_bit_cast(s16x4, __builtin_amdgcn_ds_read_tr16_b64_v4i16((LAS v4i16_t*)(lds + off + 8 * L::VST)));
                    const bf16x8 va = (bf16x8){lo[0], lo[1], lo[2], lo[3], hh[0], hh[1], hh[2], hh[3]};
                    o[d] = __builtin_amdgcn_mfma_f32_32x32x16_bf16(va, pb, o[d], 0, 0, 0); } }
        if (t + 1 < nt) { *(LAS v4u*)(lds + bn + klds) = kreg;
#pragma unroll
            for (int i = 0; i < NV; ++i) *(LAS v4u*)(lds + bn + vlds[i]) = vreg[i]; }
        __syncthreads();
    }
    lsum_out = pl32_sum(lsum);
}
__device__ __forceinline__ void load_qf(const bf16* Q  , int lane, bf16x8 (&qf)[4]) {
    const bf16* p = Q + (size_t)(lane & 31) * 512 + (lane >> 5) * 8;
#pragma unroll
    for (int s = 0; s < 4; ++s) qf[s] = *(const bf16x8*)(p + 16 * s);
}
__device__ __forceinline__ void attn_unit_a(const Frame& F, int seq, int hq, int qb) {
    const bf16* QA = (const bf16*)(F.big + B_QA); const bf16* KA = (const bf16*)(F.big + B_KA); const bf16* VA = (const bf16*)(F.big + B_VA); bf16* OA = (bf16*)(F.big + B_OA);
    const bool smp = seq >= 32; const int nk = smp ? 1280 : 256; const size_t kb = key_base(seq); const int m0 = (smp ? MP + 1024 * (seq - 32) : 256 * seq) + 256 * qb + 32 * F.wave;
    bf16x8 qf[4]; load_qf(QA + (size_t)m0 * 512 + hq * 64, F.lane, qf);
    f32x16 o[2]; float ls;
    attn_stream<64>(F, qf, KA + ((size_t)(hq >> 2) * NKEYS + kb) * 64, VA + ((size_t)(hq >> 2) * NKEYS + kb) * 64, nk, o, ls);
    const float rl = 1.0f / ls; const int hi = F.lane >> 5; bf16* op = OA + (size_t)(m0 + (F.lane & 31)) * 512 + hq * 64 + 4 * hi;
#pragma unroll
    for (int d = 0; d < 2; ++d)
#pragma unroll
        for (int g = 0; g < 4; ++g) { unsigned long long w = (unsigned long long)pk2(o[d][4 * g] * rl, o[d][4 * g + 1] * rl) | ((unsigned long long)pk2(o[d][4 * g + 2] * rl, o[d][4 * g + 3] * rl) << 32);
            *(unsigned long long*)(op + 32 * d + 8 * g) = w; }
}
__device__ __forceinline__ void attn_unit_b(const Frame& F, int l, int seq, int h, int qb) {
    const bf16* QB = (const bf16*)(F.big + B_QB); const bf16* KB = (const bf16*)(F.big + B_KB); const bf16* VB = (const bf16*)(F.big + B_VB); bf16* OB = (bf16*)(F.big + B_OB);
    const bool smp = seq >= 32; const int nk = smp ? 1280 : 256; const size_t kb = key_base(seq); const int m0 = (smp ? MP + 1024 * (seq - 32) : 256 * seq) + 256 * qb + 32 * F.wave;
    const float lam = ((const float*)(F.ws + WS_LAM))[l], lam_init = 0.8f - 0.6f * __expf(-0.3f * (float)l);
    bf16x8 qf[4]; float l1, l2; LAS v4u* o1l = (LAS v4u*)(F.lds + 2 * AttnLds<128>::BUF + F.wave * 8192) + F.lane;
    { f32x16 o1[4];
      load_qf(QB + (size_t)m0 * 512 + h * 128, F.lane, qf);
      attn_stream<128>(F, qf, KB + ((size_t)(h * 2 + 0) * NKEYS + kb) * 64, VB + ((size_t)h * NKEYS + kb) * 128, nk, o1, l1);
      const float r1 = 1.0f / l1;
#pragma unroll
      for (int d = 0; d < 4; ++d)
#pragma unroll
          for (int j = 0; j < 2; ++j) { v4u w; w.x = pg8::cvt_pk_bf16(o1[d][8 * j] * r1, o1[d][8 * j + 1] * r1); w.y = pg8::cvt_pk_bf16(o1[d][8 * j + 2] * r1, o1[d][8 * j + 3] * r1);
              w.z = pg8::cvt_pk_bf16(o1[d][8 * j + 4] * r1, o1[d][8 * j + 5] * r1); w.w = pg8::cvt_pk_bf16(o1[d][8 * j + 6] * r1, o1[d][8 * j + 7] * r1); o1l[(2 * d + j) * 64] = w; } }
    f32x16 o1[4];
    { f32x16 o2[4];
      load_qf(QB + (size_t)m0 * 512 + h * 128 + 64, F.lane, qf);
      attn_stream<128>(F, qf, KB + ((size_t)(h * 2 + 1) * NKEYS + kb) * 64, VB + ((size_t)h * NKEYS + kb) * 128, nk, o2, l2);
      const float r2 = lam / l2;
#pragma unroll
      for (int d = 0; d < 4; ++d)
#pragma unroll
          for (int j = 0; j < 2; ++j) { const v4u w = o1l[(2 * d + j) * 64];
#pragma unroll
              for (int e = 0; e < 4; ++e) { o1[d][8 * j + 2 * e] = bflo(w[e]) - o2[d][8 * j + 2 * e] * r2; o1[d][8 * j + 2 * e + 1] = bfhi(w[e]) - o2[d][8 * j + 2 * e + 1] * r2; } } }
    float ss = 0.f;
#pragma unroll
    for (int d = 0; d < 4; ++d)
#pragma unroll
        for (int r = 0; r < 16; ++r) ss += o1[d][r] * o1[d][r];
    const float rn = rsqrtf(pl32_sum(ss) * (1.0f / 128.0f) + RMS_EPS) * (1.0f - lam_init);
    const int hi = F.lane >> 5; const float* sg = F.tbl[18] + (size_t)l * 128 + 4 * hi; bf16* op = OB + (size_t)(m0 + (F.lane & 31)) * 512 + h * 128 + 4 * hi;
#pragma unroll
    for (int d = 0; d < 4; ++d)
#pragma unroll
        for (int g = 0; g < 4; ++g) { const f32x4 gv = *(const f32x4*)(sg + 32 * d + 8 * g);
            unsigned long long w = (unsigned long long)pk2(o1[d][4 * g] * rn * gv[0], o1[d][4 * g + 1] * rn * gv[1]) | ((unsigned long long)pk2(o1[d][4 * g + 2] * rn * gv[2], o1[d][4 * g + 3] * rn * gv[3]) << 32);
            *(unsigned long long*)(op + 32 * d + 8 * g) = w; }
}
typedef float f32x2 __attribute__((ext_vector_type(2)));
constexpr int SC_CH = 32, SC_STEP = 1536, SC_BUF = SC_CH * SC_STEP, SC_OUT = 2 * SC_BUF, SC_OUTB = SC_CH * 64 * 4;
template <int N> __device__ __forceinline__ float dpp_ror_add(float v) {
    return v + __int_as_float(__builtin_amdgcn_update_dpp(0, __float_as_int(v), 0x120 + N, 0xf, 0xf, false));
}
__device__ __forceinline__ float red16_dpp(float v) { v = dpp_ror_add<8>(v); v = dpp_ror_add<4>(v); v = dpp_ror_add<2>(v); v = dpp_ror_add<1>(v); return v; }
struct ScanPre { unsigned long long r, k, kk, a, w, v; };
__device__ __forceinline__ void scan_task(const Frame& F, int l, int seq, int h, int dir) {
    const RwkvBufs B = rwkv_bufs(F); bf16* OUT = (bf16*)(F.big + (dir ? B_OBW : B_OF));
    const bf16* SA = dir ? B.SA1 : B.SA0; const _Float16* SW = dir ? B.SW1 : B.SW0;
    const bool smp = seq >= 32; const int T = smp ? 1024 : 256, m0 = smp ? MP + 1024 * (seq - 32) : 256 * seq;
    const int tid = F.tid, lane = F.lane, i = lane & 15, rl = lane >> 4, row0 = 8 * F.wave + 2 * rl;
    LAS unsigned char* lds = F.lds;
    const int sl = tid >> 4, cc = tid & 15; const f32x4 ka4 = *(const f32x4*)(F.tbl[26] + (size_t)l * 512 + h * 64 + 4 * cc);
    f32x2 S[2][2];
    if (smp) { const float* sp = F.tbl[6] + ((size_t)((((seq - 32) * 2 + l) * 2 + dir) * 8 + h) * 64 + row0) * 64 + 4 * i;
        const f32x4 a = *(const f32x4*)sp, b = *(const f32x4*)(sp + 64); S[0][0] = (f32x2){a[0], a[1]}; S[0][1] = (f32x2){a[2], a[3]}; S[1][0] = (f32x2){b[0], b[1]}; S[1][1] = (f32x2){b[2], b[3]}; }
    else { S[0][0] = S[0][1] = S[1][0] = S[1][1] = (f32x2){0.f, 0.f}; }
    const int nch = T / SC_CH;
    ScanPre pre;
#define SC_LOAD(c) do { const int st_ = (c) * SC_CH + sl; const int t_ = dir ? T - 1 - st_ : st_; const size_t o_ = (size_t)(m0 + t_) * 512 + h * 64 + 4 * cc; \
        pre.r = *(const unsigned long long*)(B.SR + o_); pre.k = *(const unsigned long long*)(B.SK + o_); pre.kk = *(const unsigned long long*)(B.SKK + o_); \
        pre.a = *(const unsigned long long*)(SA + o_); pre.w = *(const unsigned long long*)(SW + o_); pre.v = *(const unsigned long long*)(B.SV + o_); } while (0)
#define SC_STAGE(bufoff) do { float r_[4], k_[4], kk_[4], a_[4], v_[4]; unpack4(pre.r, r_); unpack4(pre.k, k_); unpack4(pre.kk, kk_); unpack4(pre.a, a_); unpack4(pre.v, v_); \
        typedef _Float16 h4_ __attribute__((ext_vector_type(4))); const h4_ wv_ = __builtin_bit_cast(h4_, pre.w); f32x4 w4_, kka_, kh_; \
        _Pragma("unroll") for (int c_ = 0; c_ < 4; ++c_) { w4_[c_] = (float)wv_[c_]; kka_[c_] = kk_[c_] * a_[c_]; kh_[c_] = k_[c_] * (1.0f + (a_[c_] - 1.0f) * ka4[c_]); } \
        LAS unsigned char* d_ = lds + (bufoff) + sl * SC_STEP + cc * 16; \
        *(LAS f32x4*)(d_) = (f32x4){r_[0], r_[1], r_[2], r_[3]}; *(LAS f32x4*)(d_ + 256) = w4_; *(LAS f32x4*)(d_ + 512) = (f32x4){kk_[0], kk_[1], kk_[2], kk_[3]}; \
        *(LAS f32x4*)(d_ + 768) = kka_; *(LAS f32x4*)(d_ + 1024) = kh_; *(LAS f32x4*)(d_ + 1280) = (f32x4){v_[0], v_[1], v_[2], v_[3]}; } while (0)
    SC_LOAD(0); SC_STAGE(0);
    __syncthreads();
    for (int c = 0; c < nch; ++c) {
        const int bo = (c & 1) * SC_BUF, bn = ((c + 1) & 1) * SC_BUF; LAS float* outl = (LAS float*)(lds + SC_OUT + (c & 1) * SC_OUTB);
        if (c + 1 < nch) SC_LOAD(c + 1);
        float keep[2][2] = {{0.f, 0.f}, {0.f, 0.f}};
        const LAS unsigned char* pb_ = lds + bo + i * 16; const LAS unsigned char* pv_ = lds + bo + 1280 + row0 * 4;
        f32x4 r4 = *(const LAS f32x4*)pb_, w4 = *(const LAS f32x4*)(pb_ + 256), kk4 = *(const LAS f32x4*)(pb_ + 512), kka4 = *(const LAS f32x4*)(pb_ + 768), kh4 = *(const LAS f32x4*)(pb_ + 1024);
        f32x2 vv = *(const LAS f32x2*)pv_;
#pragma unroll
        for (int s = 0; s < SC_CH; ++s) {
            f32x4 nr4 = r4, nw4 = w4, nkk4 = kk4, nkka4 = kka4, nkh4 = kh4; f32x2 nvv = vv;
            if (s + 1 < SC_CH) { const LAS unsigned char* p = pb_ + (s + 1) * SC_STEP;
                nr4 = *(const LAS f32x4*)p; nw4 = *(const LAS f32x4*)(p + 256); nkk4 = *(const LAS f32x4*)(p + 512); nkka4 = *(const LAS f32x4*)(p + 768); nkh4 = *(const LAS f32x4*)(p + 1024);
                nvv = *(const LAS f32x2*)(pv_ + (s + 1) * SC_STEP); }
            const f32x2 r01 = {r4[0], r4[1]}, r23 = {r4[2], r4[3]}, w01 = {w4[0], w4[1]}, w23 = {w4[2], w4[3]}, k01 = {kk4[0], kk4[1]}, k23 = {kk4[2], kk4[3]};
            const f32x2 a01 = {kka4[0], kka4[1]}, a23 = {kka4[2], kka4[3]}, h01 = {kh4[0], kh4[1]}, h23 = {kh4[2], kh4[3]};
#pragma unroll
            for (int rr = 0; rr < 2; ++rr) {
                f32x2 d = S[rr][0] * k01; d = __builtin_elementwise_fma(S[rr][1], k23, d);
                const float vr = rr ? vv[1] : vv[0]; const f32x2 v2 = {vr, vr};
                const f32x2 t0 = __builtin_elementwise_fma(v2, h01, S[rr][0] * w01), t1 = __builtin_elementwise_fma(v2, h23, S[rr][1] * w23);
                const float sa = -red16_dpp(d[0] + d[1]); const f32x2 sa2 = {sa, sa};
                S[rr][0] = __builtin_elementwise_fma(sa2, a01, t0); S[rr][1] = __builtin_elementwise_fma(sa2, a23, t1);
                f32x2 od = S[rr][0] * r01; od = __builtin_elementwise_fma(S[rr][1], r23, od);
                const float ov = red16_dpp(od[0] + od[1]);
                keep[rr][s >> 4] = (i == (s & 15)) ? ov : keep[rr][s >> 4];
            }
            r4 = nr4; w4 = nw4; kk4 = nkk4; kka4 = nkka4; kh4 = nkh4; vv = nvv;
        }
#pragma unroll
        for (int q = 0; q < 2; ++q) { outl[(i + 16 * q) * 64 + row0] = keep[0][q]; outl[(i + 16 * q) * 64 + row0 + 1] = keep[1][q]; }
        if (c + 1 < nch) SC_STAGE(bn);
        __syncthreads();
        { const f32x4 ov4 = *(const LAS f32x4*)(outl + sl * 64 + 4 * cc); const int st = c * SC_CH + sl, t = dir ? T - 1 - st : st;
          *(unsigned long long*)(OUT + (size_t)(m0 + t) * 512 + h * 64 + 4 * cc) = (unsigned long long)pk2(ov4[0], ov4[1]) | ((unsigned long long)pk2(ov4[2], ov4[3]) << 32); }
    }
#undef SC_LOAD
#undef SC_STAGE
    if (!smp) { float* sp = F.out + O_NST + ((size_t)(((seq * 2 + l) * 2 + dir) * 8 + h) * 64 + row0) * 64 + 4 * i;
        *(f32x4*)sp = (f32x4){S[0][0][0], S[0][0][1], S[0][1][0], S[0][1][1]}; *(f32x4*)(sp + 64) = (f32x4){S[1][0][0], S[1][0][1], S[1][1][0], S[1][1][1]}; }
    __syncthreads();
}
constexpr int CW_QUEUE = 2048;
constexpr int QT0 = 64, QT1 = QT0 + 64, QT2 = QT1 + 128, QT3 = QT2 + 512, QT4 = QT3 + 128, QT5 = QT4 + 256;
#ifndef MIX_DYN
#define MIX_DYN 1
#endif
#ifndef MIX_ATT
#define MIX_ATT 1
#endif
#ifndef MIX_SCAN
#define MIX_SCAN 1
#endif
__device__ __forceinline__ void phase_mixer(const Frame& F0m, int l, int rep) {
    unsigned* ctr = (unsigned*)(F0m.ws + WS_CTL) + CW_QUEUE + 64 * l + 32 * rep; volatile LAS unsigned* slot = (volatile LAS unsigned*)(F0m.lds + MISC_OFF) + 16;
#if MIX_DYN
    for (;;) {
        __syncthreads();
        if (F0m.tid == 0) slot[0] = __hip_atomic_fetch_add(ctr, 1u, __ATOMIC_RELAXED, __HIP_MEMORY_SCOPE_AGENT);
        __syncthreads();
        const int task = (int)slot[0];
        if (task >= QT5) break;
#else
    for (int task = F0m.bid; task < QT5; task += F0m.G) {
        __syncthreads();
#endif
        Frame FT = F0m; asm volatile("" : "+s"(FT.big), "+s"(FT.ws), "+s"(FT.out), "+s"(FT.tbl), "+v"(FT.tid), "+v"(FT.lane));
        const Frame& F = FT;
#ifdef REP_ONLY
        const bool do_scan = !(rep && REP_ONLY == 2), do_att = !(rep && REP_ONLY == 1);
#else
        const bool do_scan = true, do_att = true;
#endif
        if (task < QT0) { if (MIX_SCAN && do_scan) scan_task(F, l, 32 + (task >> 4), (task >> 1) & 7, task & 1); }
        else if (task < QT1) { const int u = task - QT0; if (MIX_ATT && do_att) attn_unit_b(F, l, 32 + (u >> 4), (u >> 2) & 3, u & 3); }
        else if (task < QT2) { const int u = task - QT1; if (MIX_ATT && do_att) attn_unit_a(F, 32 + (u >> 5), (u >> 2) & 7, u & 3); }
        else if (task < QT3) { const int u = task - QT2; if (MIX_SCAN && do_scan) scan_task(F, l, u >> 4, (u >> 1) & 7, u & 1); }
        else if (task < QT4) { const int u = task - QT3; if (MIX_ATT && do_att) attn_unit_b(F, l, u >> 2, u & 3, 0); }
        else { const int u = task - QT4; if (MIX_ATT && do_att) attn_unit_a(F, u >> 3, u & 7, 0); }
    }
    if (!MIX_SCAN) phase_scan(F0m, l);
    if (!MIX_ATT) phase_attn_naive(F0m, l);
}
constexpr int PH_PER_LAYER = 16, N_PHASES = 2 + NL * PH_PER_LAYER;
template <class Epi> __device__ __forceinline__ void run_gemm(const Frame& F, const bf16* A, const bf16* Bt, int N, int K, const Epi& E) {
    pg8::Gemm g{A, Bt, M, N, K}; pg8::StaticOrder S; S.init(M, N, F.G, F.bid);
    pg8::gemm_phase<Epi, pg8::StaticOrder, true, true>(F.lds + RING_OFF, g, S, E);
}
#define PHON(k) ((PHMASK >> (k)) & 1)
template <unsigned PHMASK> __device__ __forceinline__ void run_phase(const Frame& F0, int ph, int rep = 0) {
#define LAUNDER() Frame F = F0; asm volatile("" : "+s"(F.ws), "+s"(F.big), "+s"(F.out), "+s"(F.tbl))
    if (ph == 0) { LAUNDER(); if (PHON(0)) phase_conv(F); return; }
    if (ph == 1) { LAUNDER(); if (PHON(1)) phase_init(F); return; }
    const int l = (ph - 2) / PH_PER_LAYER, s = (ph - 2) % PH_PER_LAYER;
    if (PHON(2) && (s == 0 || s == 13)) { LAUNDER(); bf16* wl = wlayer(F, l); const bf16* H = (const bf16*)(F.ws + WS_H); pg8::EpiSwiglu E{(bf16*)(F.big + B_ACT), FF}; run_gemm(F, H, wl + (s ? WL_W2A : WL_W1A), 2 * FF, DM, E); }
    else if (PHON(3) && (s == 1 || s == 11 || s == 14)) { LAUNDER(); bf16* wl = wlayer(F, l);
        const bf16* A = s == 11 ? (const bf16*)(F.big + B_GU) : (const bf16*)(F.big + B_ACT); const int K = s == 11 ? DM : FF;
        const bf16* Bt = wl + (s == 1 ? WL_W1B : s == 11 ? WL_WO : WL_W2B); pg8::EpiF32 E{(float*)(F.big + (s == 11 ? B_Z1 : B_Z2)), DM}; run_gemm(F, A, Bt, DM, K, E); }
    else if (PHON(4) && (s == 2 || s == 12 || s == 15)) { LAUNDER(); phase_ln(F, l, s == 2 ? 0 : s == 12 ? 1 : 2, (const float*)(F.big + (s == 12 ? B_Z1 : B_Z2))); }
    else if (PHON(5) && (s == 3 || s == 5 || s == 9)) { LAUNDER(); bf16* wl = wlayer(F, l); const bf16* H = (const bf16*)(F.ws + WS_H);
        const int r0 = s == 3 ? WIN_ATT : s == 5 ? WIN_RWKV : WIN_GATE, N = s == 3 ? 2304 : s == 5 ? 2048 : 3072;
        pg8::EpiBf E{(bf16*)(F.big + (s == 3 ? B_PQA : s == 5 ? B_PQR : B_GATES)), N, s == 9 ? 1 : 0}; run_gemm(F, H, wl + WL_WIN + (size_t)r0 * DM, N, DM, E); }
    else if (PHON(6) && s == 4) { LAUNDER(); phase_attprep(F, l); }
    else if (PHON(7) && s == 6) { LAUNDER(); phase_rwkvprep(F, l); }
    else if (s == 7) { LAUNDER();
        if (PHON(8)) phase_mixer(F, l, rep);
    }
    else if (PHON(10) && s == 8) { LAUNDER(); phase_rwkvpost(F, l); }
    else if (PHON(11) && s == 10) { LAUNDER(); bf16* wl = wlayer(F, l);
        for (int i = 0; i < 3; ++i) { const bf16* A = (const bf16*)(F.big + (i == 0 ? B_OA : i == 1 ? B_OB : B_OC));
            pg8::EpiUp E{(const bf16*)(F.big + B_GATES), 3072, i * 1024, (float*)(F.big + B_T), (bf16*)(F.big + B_GU), i}; run_gemm(F, A, wl + WL_WUP + (size_t)i * 524288, DM, 512, E); } }
}
template <unsigned PHMASK> __global__ void __launch_bounds__(NWAVES * 64, 2) fwd_t(Args args) {
    extern __shared__ __attribute__((aligned(16))) unsigned char lds[];
    Frame F;
    F.lds = (LAS unsigned char*)lds; F.tid = threadIdx.x; F.lane = F.tid & 63; F.wave = __builtin_amdgcn_readfirstlane(F.tid >> 6);
    F.G = gridDim.x; F.bid = blockIdx.x; F.gw = F.bid * NWAVES + F.wave; F.NGW = F.G * NWAVES;
    F.out = args.out; F.ws = args.ws; F.big = args.ws + WS_BIG;
    for (int u = F.tid; u < (LDS_BYTES - LDSCTL_OFF) / 4; u += NWAVES * 64) ((LAS unsigned*)(F.lds + LDSCTL_OFF))[u] = 0u;
    { const float** t = (const float**)(args.ws + WS_PTRS + (size_t)F.bid * 256);
      if (F.tid == 0) {
#pragma unroll
          for (int i = 0; i < 32; ++i) t[i] = args.in[i];
      }
      F.tbl = t; }
    asm volatile("s_waitcnt vmcnt(0)" ::: "memory");
    __syncthreads();
    const int lo = args.ph_lo, hi = args.ph_hi;
    XcdBarrier bar; bar.bar = (unsigned*)(args.ws + WS_CTL) + CW_BAR; bar.x = 0; bar.st = nullptr;
    if (hi - lo > 1) bar = xcd_barrier_post((unsigned*)(args.ws + WS_CTL) + CW_BAR, (volatile LAS unsigned*)(F.lds + MISC_OFF) + 8);
    for (int ph = lo; ph < hi; ++ph) {
        Frame FL = F;
        asm volatile("" : "+s"(FL.ws), "+s"(FL.big), "+s"(FL.out), "+s"(FL.tbl), "+v"(FL.lane), "+v"(FL.tid), "+s"(FL.wave), "+s"(FL.G), "+s"(FL.bid), "+s"(FL.gw), "+s"(FL.NGW));
        int ph_ = ph; asm volatile("" : "+s"(ph_));
        run_phase<PHMASK>(FL, ph_, args.rep0);
        if (ph + 1 < hi) xcd_barrier(bar);
    }
}
#define fwd fwd_t<0xffffu>
static int phase_kind(int ph) { if (ph < 2) return ph; const int s = (ph - 2) % PH_PER_LAYER; const int k[16] = {2, 3, 4, 5, 6, 5, 7, 8, 10, 5, 11, 3, 4, 2, 3, 4}; return k[s]; }
template <unsigned MASK> static void launch_one(int grid, hipStream_t stream, const Args& a) { (void)hipFuncSetAttribute((const void*)fwd_t<MASK>, hipFuncAttributeMaxDynamicSharedMemorySize, LDS_BYTES); hipLaunchKernelGGL(fwd_t<MASK>, dim3(grid), dim3(NWAVES * 64), LDS_BYTES, stream, a); }
extern "C" void kernel_launch(void* const* d_in, const int* in_sizes, int n_in, void* d_out, int out_size, void* d_ws, size_t ws_size, hipStream_t stream) {
    static int grid = 0;
    if (grid == 0) {
        if (n_in != 32 || out_size != (int)O_TOTAL || ws_size < WS_END) { fprintf(stderr, "kernel_launch: unexpected problem: n_in %d out %d ws %zu (need %zu)\n", n_in, out_size, ws_size, (size_t)WS_END); grid = -1; return; }
        int dev = 0, cus = 0, per_cu = 0;
        if (hipGetDevice(&dev) != hipSuccess || hipDeviceGetAttribute(&cus, hipDeviceAttributeMultiprocessorCount, dev) != hipSuccess) { grid = -1; return; }
        if (hipFuncSetAttribute((const void*)fwd, hipFuncAttributeMaxDynamicSharedMemorySize, LDS_BYTES) != hipSuccess) { fprintf(stderr, "kernel_launch: hipFuncSetAttribute failed\n"); grid = -1; return; }
        if (hipOccupancyMaxActiveBlocksPerMultiprocessor(&per_cu, (const void*)fwd, NWAVES * 64, LDS_BYTES) != hipSuccess || per_cu < 1) { fprintf(stderr, "kernel_launch: occupancy query says %d blocks per CU\n", per_cu); (void)hipGetLastError(); per_cu = 1; }
        grid = cus;
        if (grid > 256) grid = 256;
    }
    if (grid < 0) return;
    (void)hipMemsetAsync((char*)d_ws + WS_CTL, 0, CTL_ZERO_BYTES, stream);
    Args a{};
    for (int i = 0; i < 32; ++i) a.in[i] = (const float*)d_in[i];
    a.out = (float*)d_out; a.ws = (unsigned char*)d_ws;
#if MK_ONE_LAUNCH
    a.ph_lo = 0; a.ph_hi = N_PHASES;
    hipLaunchKernelGGL(fwd, dim3(grid), dim3(NWAVES * 64), LDS_BYTES, stream, a);
#else
#ifndef REPEAT_MASK
#define REPEAT_MASK 0
#endif
    for (int ph = 0; ph < N_PHASES; ++ph) { a.ph_lo = ph; a.ph_hi = ph + 1; const int kind = phase_kind(ph); const int nrep = ((REPEAT_MASK >> kind) & 1) ? 2 : 1;
        for (int rep = 0; rep < nrep; ++rep) { a.rep0 = rep;
            switch (kind) { case 0: launch_one<1u << 0>(grid, stream, a); break; case 1: launch_one<1u << 1>(grid, stream, a); break; case 2: launch_one<1u << 2>(grid, stream, a); break; case 3: launch_one<1u << 3>(grid, stream, a); break; case 4: launch_one<1u << 4>(grid, stream, a); break;
                case 5: launch_one<1u << 5>(grid, stream, a); break; case 6: launch_one<1u << 6>(grid, stream, a); break; case 7: launch_one<1u << 7>(grid, stream, a); break;
                case 8: launch_one<1u << 8>(grid, stream, a); break; case 10: launch_one<1u << 10>(grid, stream, a); break; default: launch_one<1u << 11>(grid, stream, a); break; } } }
#endif
}
```
